# Optimizing an MI355X kernel written in HIP

```python
import jax, jax.numpy as jnp
from jax import lax
import numpy as np

D_MODEL = 1024
BATCH = 16
SEQ = 2048
DEPTH = 2

CHUNK = 64
QBLK = 128
HEAD_DIM = 64
SB_HEADS = 4
FOX_HEADS = 4
MLA_HEADS = 8
MLA_Q_RANK = 256
MLA_KV_RANK = 128
MLA_NOPE_DIM = 64
MLA_ROPE_DIM = 32
MLA_V_DIM = 64
ROPE_BASE = 10000.0
N_BRANCHES = 3
N_EXPERTS = 256
TOP_K = 8
N_GROUPS = 8
TOPK_GROUPS = 4
EXPERT_FF = 256
SHARED_FF = 256
ROUTED_SCALE = 2.5
MOE_BLOCK = 128
LN_EPS = 1e-5
RMS_EPS = 1e-6
DN_ALPHA = (2 * DEPTH) ** 0.25
DN_BETA = (8 * DEPTH) ** -0.25

SB_W = SB_HEADS * HEAD_DIM
FOX_W = FOX_HEADS * HEAD_DIM
MLA_QK_DIM = MLA_NOPE_DIM + MLA_ROPE_DIM
OFF_SB = 0
OFF_FOX = OFF_SB + 3 * SB_W
OFF_FGATE = OFF_FOX + 3 * FOX_W
OFF_DQ = OFF_FGATE + FOX_HEADS
OFF_DKV = OFF_DQ + MLA_Q_RANK
OFF_KR = OFF_DKV + MLA_KV_RANK
OFF_GATE = OFF_KR + MLA_ROPE_DIM
IN_WIDTH = OFF_GATE + N_BRANCHES * D_MODEL

kernel_name = "hybrid_sb_fox_mla_moe_deepnorm"


def _layer_norm(x, g, b):
    xf = x.astype(jnp.float32)
    xc = xf - jnp.mean(xf, axis=-1, keepdims=True)
    var = jnp.mean(xc * xc, axis=-1, keepdims=True)
    y = xc * lax.rsqrt(var + LN_EPS) * g.astype(jnp.float32) + b.astype(jnp.float32)
    return y.astype(x.dtype)


def _rms_norm(x, g):
    xf = x.astype(jnp.float32)
    y = xf * lax.rsqrt(jnp.mean(xf * xf, axis=-1, keepdims=True) + RMS_EPS) * g.astype(jnp.float32)
    return y.astype(x.dtype)


def _rope(x, positions):
    half = MLA_ROPE_DIM // 2
    inv_freq = jnp.power(ROPE_BASE, -jnp.arange(half, dtype=jnp.float32) / half)
    ang = positions.astype(jnp.float32)[:, None] * inv_freq[None, :]
    cos, sin = jnp.cos(ang), jnp.sin(ang)
    x1 = x[..., :half].astype(jnp.float32)
    x2 = x[..., half:].astype(jnp.float32)
    return jnp.concatenate([x1 * cos - x2 * sin, x1 * sin + x2 * cos], axis=-1).astype(x.dtype)


def _heads(t, n_heads):
    b, s, _ = t.shape
    return t.reshape(b, s, n_heads, -1).transpose(0, 2, 1, 3)


def _merge_heads(t):
    b, h, s, d = t.shape
    return t.transpose(0, 2, 1, 3).reshape(b, s, h * d)


def _stick_breaking(q, k, v, t_pos, s_pos):
    z = jnp.einsum('bhtd,bhsd->bhts', q, k).astype(jnp.float32) * (HEAD_DIM ** -0.5)
    strict = s_pos[None, :] < t_pos[:, None]
    log_keep = jnp.where(strict, jax.nn.log_sigmoid(-z), 0.0)
    between = lax.cumsum(log_keep, axis=3, reverse=True) - log_keep
    w = jnp.where(strict, jnp.exp(jax.nn.log_sigmoid(z) + between), 0.0)
    return jnp.einsum('bhts,bhsd->bhtd', w.astype(v.dtype), v)


def _forgetting(q, k, v, cum_t, cum_s, t_pos, s_pos):
    logits = jnp.einsum('bhtd,bhsd->bhts', q, k).astype(jnp.float32) * (HEAD_DIM ** -0.5)
    logits = logits + (cum_t[..., :, None] - cum_s[..., None, :])
    causal = s_pos[None, :] <= t_pos[:, None]
    p = jax.nn.softmax(jnp.where(causal, logits, -jnp.inf), axis=-1)
    return jnp.einsum('bhts,bhsd->bhtd', p.astype(v.dtype), v)


def _mla_block(q_nope, q_rope, k_nope, k_rope, v, t_pos, s_pos):
    logits = (jnp.einsum('bhtd,bhsd->bhts', q_nope, k_nope)
              + jnp.einsum('bhtr,bsr->bhts', q_rope, k_rope)).astype(jnp.float32) * (MLA_QK_DIM ** -0.5)
    chunk_causal = (s_pos[None, :] // CHUNK) <= (t_pos[:, None] // CHUNK)
    p = jax.nn.softmax(jnp.where(chunk_causal, logits, -jnp.inf), axis=-1)
    return jnp.einsum('bhts,bhsd->bhtd', p.astype(v.dtype), v)


def _token_mixers(x, w_in, b_gate, b_forget, mla_q_norm, w_uq, mla_kv_norm, w_ukv,
                  w_proj_sb, w_proj_fox, w_proj_mla, w_out):
    b, s, _ = x.shape
    p = x @ w_in
    q_sb = _heads(p[..., OFF_SB:OFF_SB + SB_W], SB_HEADS)
    k_sb = _heads(p[..., OFF_SB + SB_W:OFF_SB + 2 * SB_W], SB_HEADS)
    v_sb = _heads(p[..., OFF_SB + 2 * SB_W:OFF_FOX], SB_HEADS)
    q_fox = _heads(p[..., OFF_FOX:OFF_FOX + FOX_W], FOX_HEADS)
    k_fox = _heads(p[..., OFF_FOX + FOX_W:OFF_FOX + 2 * FOX_W], FOX_HEADS)
    v_fox = _heads(p[..., OFF_FOX + 2 * FOX_W:OFF_FGATE], FOX_HEADS)
    log_f = jax.nn.log_sigmoid((p[..., OFF_FGATE:OFF_DQ] + b_forget).astype(jnp.float32))
    cum_f = jnp.swapaxes(lax.cumsum(log_f, axis=1), 1, 2)

    pos = jnp.arange(s)
    c_q = _rms_norm(p[..., OFF_DQ:OFF_DKV], mla_q_norm)
    q_mla = _heads(c_q @ w_uq, MLA_HEADS)
    q_nope = q_mla[..., :MLA_NOPE_DIM]
    q_rope = _rope(q_mla[..., MLA_NOPE_DIM:], pos)
    c_kv = _rms_norm(p[..., OFF_DKV:OFF_KR], mla_kv_norm)
    kv = _heads(c_kv @ w_ukv, MLA_HEADS)
    k_nope = kv[..., :MLA_NOPE_DIM]
    v_mla = kv[..., MLA_NOPE_DIM:]
    k_rope = _rope(p[..., OFF_KR:OFF_GATE], pos)

    gates = jax.nn.sigmoid(p[..., OFF_GATE:] + b_gate).reshape(b, s, N_BRANCHES, D_MODEL)

    out_sb, out_fox, out_mla = [], [], []
    for i in range(s // QBLK):
        q0, q1 = i * QBLK, (i + 1) * QBLK
        t_pos = jnp.arange(q0, q1)
        s_pos = jnp.arange(q1)
        out_sb.append(_stick_breaking(q_sb[:, :, q0:q1], k_sb[:, :, :q1], v_sb[:, :, :q1], t_pos, s_pos))
        out_fox.append(_forgetting(q_fox[:, :, q0:q1], k_fox[:, :, :q1], v_fox[:, :, :q1],
                                   cum_f[:, :, q0:q1], cum_f[:, :, :q1], t_pos, s_pos))
        out_mla.append(_mla_block(q_nope[:, :, q0:q1], q_rope[:, :, q0:q1], k_nope[:, :, :q1],
                                  k_rope[:, :q1], v_mla[:, :, :q1], t_pos, s_pos))
    o_sb = _merge_heads(jnp.concatenate(out_sb, axis=2))
    o_fox = _merge_heads(jnp.concatenate(out_fox, axis=2))
    o_mla = _merge_heads(jnp.concatenate(out_mla, axis=2))

    mixed = (gates[..., 0, :] * (o_sb @ w_proj_sb)
             + gates[..., 1, :] * (o_fox @ w_proj_fox)
             + gates[..., 2, :] * (o_mla @ w_proj_mla))
    return mixed @ w_out


def _swiglu(x, wg, wu, wd):
    return (jax.nn.silu(x @ wg) * (x @ wu)) @ wd


def _route(xf, w_router, router_bias):
    scores = jax.nn.sigmoid((xf @ w_router).astype(jnp.float32))
    biased = scores + router_bias.astype(jnp.float32)
    grouped = biased.reshape(-1, N_GROUPS, N_EXPERTS // N_GROUPS)
    group_score = lax.top_k(grouped, 2)[0].sum(-1)
    _, top_groups = lax.top_k(group_score, TOPK_GROUPS)
    group_keep = jnp.any(top_groups[:, :, None] == jnp.arange(N_GROUPS)[None, None, :], axis=1)
    expert_keep = jnp.repeat(group_keep, N_EXPERTS // N_GROUPS, axis=1)
    _, top_idx = lax.top_k(jnp.where(expert_keep, biased, -jnp.inf), TOP_K)
    w = jnp.take_along_axis(scores, top_idx, axis=1)
    w = w / jnp.sum(w, axis=-1, keepdims=True) * ROUTED_SCALE
    return top_idx, w.astype(xf.dtype)


def _routed_experts(xf, top_idx, top_w, w_gate, w_up, w_down):
    n_tok, d = xf.shape
    n_assign = n_tok * TOP_K
    n_blocks = -(-n_assign // MOE_BLOCK) + N_EXPERTS
    flat_e = top_idx.reshape(-1)
    order = jnp.argsort(flat_e)
    sorted_e = flat_e[order]
    counts = jnp.bincount(flat_e, length=N_EXPERTS)
    padded = (counts + MOE_BLOCK - 1) // MOE_BLOCK * MOE_BLOCK
    pad_end = jnp.cumsum(padded)
    pad_start = pad_end - padded
    grp_start = jnp.cumsum(counts) - counts
    dest = pad_start[sorted_e] + (jnp.arange(n_assign) - grp_start[sorted_e])
    n_rows = n_blocks * MOE_BLOCK
    row_tok = jnp.full((n_rows,), n_tok, jnp.int32).at[dest].set((order // TOP_K).astype(jnp.int32))
    row_w = jnp.zeros((n_rows,), xf.dtype).at[dest].set(top_w.reshape(-1)[order])
    blk_e = jnp.minimum(jnp.searchsorted(pad_end, jnp.arange(n_blocks) * MOE_BLOCK, side='right'),
                        N_EXPERTS - 1)
    x_pad = jnp.concatenate([xf, jnp.zeros((1, d), xf.dtype)], axis=0)

    def step(acc, blk):
        tok, wts, e = blk
        y = _swiglu(x_pad[tok], w_gate[e], w_up[e], w_down[e]) * wts[:, None]
        return acc.at[tok].add(y), None

    acc, _ = lax.scan(step, jnp.zeros_like(x_pad),
                      (row_tok.reshape(n_blocks, MOE_BLOCK), row_w.reshape(n_blocks, MOE_BLOCK), blk_e))
    return acc[:n_tok]


def _moe(x, w_router, router_bias, w_exp_gate, w_exp_up, w_exp_down, w_sh_gate, w_sh_up, w_sh_down):
    b, s, d = x.shape
    xf = x.reshape(b * s, d)
    top_idx, top_w = _route(xf, w_router, router_bias)
    y = _swiglu(xf, w_sh_gate, w_sh_up, w_sh_down) + _routed_experts(xf, top_idx, top_w,
                                                                      w_exp_gate, w_exp_up, w_exp_down)
    return y.reshape(b, s, d)


def setup_inputs(seed: int = 0) -> dict:
    key = jax.random.key(seed)
    ks = jax.random.split(key, 32)
    f32 = jnp.float32

    def nrm(k, shape, scale):
        return jax.random.normal(k, shape, f32) * scale

    din = D_MODEL ** -0.5
    x = nrm(ks[0], (BATCH, SEQ, D_MODEL), 1.0)
    ln1_g = 1.0 + nrm(ks[1], (DEPTH, D_MODEL), 0.02)
    ln1_b = nrm(ks[2], (DEPTH, D_MODEL), 0.02)
    ln2_g = 1.0 + nrm(ks[3], (DEPTH, D_MODEL), 0.02)
    ln2_b = nrm(ks[4], (DEPTH, D_MODEL), 0.02)
    w_in = jnp.concatenate([
        nrm(ks[5], (DEPTH, D_MODEL, 2 * SB_W), din),
        nrm(ks[6], (DEPTH, D_MODEL, SB_W), din * DN_BETA),
        nrm(ks[7], (DEPTH, D_MODEL, 2 * FOX_W), din),
        nrm(ks[8], (DEPTH, D_MODEL, FOX_W), din * DN_BETA),
        nrm(ks[9], (DEPTH, D_MODEL, IN_WIDTH - OFF_FGATE), din),
    ], axis=-1)
    b_gate = nrm(ks[10], (DEPTH, N_BRANCHES * D_MODEL), 0.1)
    b_forget = 3.0 + nrm(ks[11], (DEPTH, FOX_HEADS), 0.1)
    mla_q_norm = 1.0 + nrm(ks[12], (DEPTH, MLA_Q_RANK), 0.02)
    w_uq = nrm(ks[13], (DEPTH, MLA_Q_RANK, MLA_HEADS * MLA_QK_DIM), MLA_Q_RANK ** -0.5)
    mla_kv_norm = 1.0 + nrm(ks[14], (DEPTH, MLA_KV_RANK), 0.02)
    w_uk = nrm(ks[15], (DEPTH, MLA_KV_RANK, MLA_HEADS, MLA_NOPE_DIM), MLA_KV_RANK ** -0.5)
    w_uv = nrm(ks[16], (DEPTH, MLA_KV_RANK, MLA_HEADS, MLA_V_DIM), MLA_KV_RANK ** -0.5 * DN_BETA)
    w_ukv = jnp.concatenate([w_uk, w_uv], axis=-1).reshape(DEPTH, MLA_KV_RANK, MLA_HEADS * (MLA_NOPE_DIM + MLA_V_DIM))
    w_proj_sb = nrm(ks[17], (DEPTH, SB_W, D_MODEL), SB_W ** -0.5 * DN_BETA)
    w_proj_fox = nrm(ks[18], (DEPTH, FOX_W, D_MODEL), FOX_W ** -0.5 * DN_BETA)
    w_proj_mla = nrm(ks[19], (DEPTH, MLA_HEADS * MLA_V_DIM, D_MODEL), (MLA_HEADS * MLA_V_DIM) ** -0.5 * DN_BETA)
    w_out = nrm(ks[20], (DEPTH, D_MODEL, D_MODEL), din * DN_BETA)
    w_router = nrm(ks[21], (DEPTH, D_MODEL, N_EXPERTS), din)
    router_bias = nrm(ks[22], (DEPTH, N_EXPERTS), 0.01)
    w_exp_gate = nrm(ks[23], (DEPTH, N_EXPERTS, D_MODEL, EXPERT_FF), din)
    w_exp_up = nrm(ks[24], (DEPTH, N_EXPERTS, D_MODEL, EXPERT_FF), din)
    w_exp_down = nrm(ks[25], (DEPTH, N_EXPERTS, EXPERT_FF, D_MODEL), EXPERT_FF ** -0.5 * DN_BETA)
    w_sh_gate = nrm(ks[26], (DEPTH, D_MODEL, SHARED_FF), din)
    w_sh_up = nrm(ks[27], (DEPTH, D_MODEL, SHARED_FF), din)
    w_sh_down = nrm(ks[28], (DEPTH, SHARED_FF, D_MODEL), SHARED_FF ** -0.5 * DN_BETA)
    return {"x": x, "ln1_g": ln1_g, "ln1_b": ln1_b, "ln2_g": ln2_g, "ln2_b": ln2_b,
            "w_in": w_in, "b_gate": b_gate, "b_forget": b_forget,
            "mla_q_norm": mla_q_norm, "w_uq": w_uq, "mla_kv_norm": mla_kv_norm, "w_ukv": w_ukv,
            "w_proj_sb": w_proj_sb, "w_proj_fox": w_proj_fox, "w_proj_mla": w_proj_mla, "w_out": w_out,
            "w_router": w_router, "router_bias": router_bias,
            "w_exp_gate": w_exp_gate, "w_exp_up": w_exp_up, "w_exp_down": w_exp_down,
            "w_sh_gate": w_sh_gate, "w_sh_up": w_sh_up, "w_sh_down": w_sh_down}


def reference(x, ln1_g, ln1_b, ln2_g, ln2_b, w_in, b_gate, b_forget, mla_q_norm, w_uq,
              mla_kv_norm, w_ukv, w_proj_sb, w_proj_fox, w_proj_mla, w_out, w_router, router_bias,
              w_exp_gate, w_exp_up, w_exp_down, w_sh_gate, w_sh_up, w_sh_down):
    for l in range(DEPTH):
        mix = _token_mixers(x, w_in[l], b_gate[l], b_forget[l], mla_q_norm[l], w_uq[l],
                            mla_kv_norm[l], w_ukv[l], w_proj_sb[l], w_proj_fox[l], w_proj_mla[l], w_out[l])
        x = _layer_norm(DN_ALPHA * x + mix, ln1_g[l], ln1_b[l])
        ffn = _moe(x, w_router[l], router_bias[l], w_exp_gate[l], w_exp_up[l], w_exp_down[l],
                   w_sh_gate[l], w_sh_up[l], w_sh_down[l])
        x = _layer_norm(DN_ALPHA * x + ffn, ln2_g[l], ln2_b[l])
    return x
```

```cpp
#include <hip/hip_runtime.h>
#include <cstdio>
#include <cstdint>

#define LAS __attribute__((address_space(3)))
#define GAS __attribute__((address_space(1)))
typedef unsigned short bf16_t;
typedef short bf16x8 __attribute__((ext_vector_type(8)));
typedef short s16x4 __attribute__((ext_vector_type(4)));
typedef float f32x2 __attribute__((ext_vector_type(2)));
typedef float f32x4 __attribute__((ext_vector_type(4)));
typedef float f32x16 __attribute__((ext_vector_type(16)));
typedef unsigned u32x2 __attribute__((ext_vector_type(2)));
typedef unsigned u32x4 __attribute__((ext_vector_type(4)));
typedef int i32x4 __attribute__((ext_vector_type(4)));
typedef int i32x8 __attribute__((ext_vector_type(8)));

constexpr int NTOK = 32768, DM = 1024, SEQ = 2048, NBATCH = 16, DEPTH = 2;
constexpr int IN_WIDTH = 5028, OFF_FGATE = 1536, OFF_DQ = 1540, OFF_DKV = 1796, OFF_KR = 1924, OFF_GATE = 1956;
constexpr int NEXP = 256, TOPK = 8, NE1 = NEXP + 1;
constexpr int NASSIGN = NTOK * TOPK;
constexpr int NROWS = NASSIGN + NTOK;
constexpr float LOG2E = 1.4426950408889634f;
constexpr float QS64 = 0.125f * LOG2E;
constexpr float QS96 = 0.10206207261596575f * LOG2E;
constexpr float DN_ALPHA = 1.4142135623730951f;
constexpr float LN_EPS = 1e-5f, RMS_EPS = 1e-6f, ROUTED_SCALE = 2.5f;
constexpr int NWAVES = 8, NTHREADS = 512;

constexpr size_t MiB = 1u << 20;
constexpr size_t WS_CTL = 0, CTL_BYTES = 1 * MiB;
constexpr size_t WS_ROPE = 1 * MiB;
constexpr size_t WS_WSMALL = 2 * MiB, WSMALL_LAYER = 20 * MiB;
constexpr size_t WOF_IN = 0;
constexpr size_t WOF_UQ = 10 * MiB;
constexpr size_t WOF_UKV = 10 * MiB + 512 * 1024;
constexpr size_t WOF_PSB = 11 * MiB;
constexpr size_t WOF_PFOX = 11 * MiB + 512 * 1024;
constexpr size_t WOF_PMLA = 12 * MiB;
constexpr size_t WOF_OUT3 = 13 * MiB;
constexpr size_t WOF_R = 19 * MiB;
constexpr size_t WS_WGU = 42 * MiB;
constexpr size_t WS_WD = WS_WGU + 257 * MiB;
constexpr size_t WS_XA = 428 * MiB;
constexpr size_t WS_XB = 556 * MiB;
constexpr size_t WS_XBF = 684 * MiB;
constexpr size_t WS_R = 748 * MiB;
constexpr size_t WS_QKV = WS_R;
constexpr size_t WS_DQKV = WS_QKV + 96 * MiB;
constexpr size_t WS_GATES = WS_DQKV + 32 * MiB;
constexpr size_t WS_QM = WS_GATES + 192 * MiB;
constexpr size_t WS_KVM = WS_QM + 48 * MiB;
constexpr size_t WS_OCAT = WS_KVM + 64 * MiB;
constexpr size_t WS_MIXG = WS_OCAT + 64 * MiB;
constexpr size_t WS_Y = WS_MIXG + 192 * MiB;
constexpr size_t WS_KR = WS_Y + 128 * MiB;
constexpr size_t WS_LOGF = WS_KR + 2 * MiB;
constexpr size_t WS_CUMF = WS_LOGF + 512 * 1024;
constexpr size_t WS_SSQ = WS_CUMF + 512 * 1024;
constexpr size_t WS_STATS = WS_SSQ + 1 * MiB;
constexpr size_t WS_ATT_END = WS_STATS + 1 * MiB;
constexpr size_t WS_LOGITS = WS_R;
constexpr size_t WS_TKI = WS_LOGITS + 32 * MiB;
constexpr size_t WS_TKW = WS_TKI + 1 * MiB;
constexpr size_t WS_INV = WS_TKW + 1 * MiB;
constexpr size_t WS_RTOK = WS_INV + 1 * MiB;
constexpr size_t WS_RW = WS_RTOK + 2 * MiB;
constexpr size_t WS_H = WS_RW + 2 * MiB;
constexpr size_t WS_YS = WS_H + 145 * MiB;
constexpr size_t WS_MOE_END = WS_YS + 577 * MiB;
constexpr size_t WS_END = (WS_ATT_END > WS_MOE_END ? WS_ATT_END : WS_MOE_END);
static_assert(WS_END <= 2000 * MiB, "workspace map");

constexpr int CW_BAR = 4096;
constexpr int CW_CNT = 65536;

constexpr int LDS_STAGE = 131072;
constexpr int LDS_TAB = LDS_STAGE;
constexpr int LDS_MISC = LDS_STAGE + 16384;
constexpr int LDS_BYTES = 160 * 1024;

typedef __bf16 bf16x2_t __attribute__((ext_vector_type(2)));
__device__ __forceinline__ unsigned cvt_pk_bf16(float lo, float hi) { const f32x2 v = {lo, hi}; const bf16x2_t b = __builtin_convertvector(v, bf16x2_t); return __builtin_bit_cast(unsigned, b); }
__device__ __forceinline__ float bf_lo(unsigned w) { return __uint_as_float(w << 16); }
__device__ __forceinline__ float bf_hi(unsigned w) { return __uint_as_float(w & 0xffff0000u); }
__device__ __forceinline__ float fast_sigmoid(float x) { return __builtin_amdgcn_rcpf(1.0f + __builtin_amdgcn_exp2f(-x * LOG2E)); }
__device__ __forceinline__ int opaque_v(int x) { asm volatile("" : "+v"(x)); return x; }
__device__ __forceinline__ int opaque_s(int x) { asm volatile("" : "+s"(x)); return x; }
__device__ __forceinline__ int lane_now() { int l; asm volatile("v_mbcnt_lo_u32_b32 %0, -1, 0\n\tv_mbcnt_hi_u32_b32 %0, -1, %0" : "=v"(l)); return l; }
template <typename T> __device__ __forceinline__ T shx(T v, int m) { return __builtin_bit_cast(T, __builtin_amdgcn_ds_bpermute((lane_now() ^ m) << 2, __builtin_bit_cast(int, v))); }
template <typename T> __device__ __forceinline__ T shup(T v, int o) { return __builtin_bit_cast(T, __builtin_amdgcn_ds_bpermute((lane_now() - o) << 2, __builtin_bit_cast(int, v))); }
__device__ __forceinline__ float sum32(float x) { const unsigned u = __float_as_uint(x); const auto r = __builtin_amdgcn_permlane32_swap(u, u, false, false); return __uint_as_float(r[0]) + __uint_as_float(r[1]); }
__device__ __forceinline__ float max32(float x) { const unsigned u = __float_as_uint(x); const auto r = __builtin_amdgcn_permlane32_swap(u, u, false, false); return fmaxf(__uint_as_float(r[0]), __uint_as_float(r[1])); }
__device__ __forceinline__ float wave_sum(float v) {
#pragma unroll
    for (int o = 1; o < 32; o <<= 1) v += shx(v, o);
    return sum32(v);
}

#define XB_TMO      128
#define XB_XCNT(j)  (256  + 64 * (j))
#define XB_XSUB(j)  (1280 + 64 * (j))
#define XB_XGEN(j)  (2304 + 64 * (j))
#define XB_TOP      3328
#define XB_TOPGEN   3392
#define XCD_BAR_WORDS 3456
#define XB_SPIN_CAP (1u << 18)
__device__ __forceinline__ unsigned xb_ld(unsigned* p)              { return __hip_atomic_load(p, __ATOMIC_RELAXED, __HIP_MEMORY_SCOPE_AGENT); }
__device__ __forceinline__ unsigned xb_add(unsigned* p, unsigned v) { return __hip_atomic_fetch_add(p, v, __ATOMIC_RELAXED, __HIP_MEMORY_SCOPE_AGENT); }
__device__ __forceinline__ unsigned xb_xcc_id() { return (unsigned)__builtin_amdgcn_s_getreg((3 << 11) | 20) & 0xFu; }
#define XB_SPIN(cond, bar) do { unsigned _sp = 0; while (cond) { __builtin_amdgcn_s_sleep(1); \
    if ((++_sp & 255u) == 0u) { if (xb_ld(&(bar)[XB_TMO])) break; if (_sp > XB_SPIN_CAP) { atomicAdd(&(bar)[XB_TMO], 1u); break; } } } } while (0)
struct XcdBarrier { unsigned* bar; unsigned x; volatile LAS unsigned* st; int wv; };
__device__ __forceinline__ XcdBarrier xcd_barrier_post(unsigned* bar, volatile LAS unsigned* st, int wv) {
    XcdBarrier b; b.bar = bar; b.x = xb_xcc_id(); b.st = st; b.wv = wv;
    if (threadIdx.x == 0) (void)xb_add(&bar[XB_XCNT(b.x)], 1u);
    return b;
}
__device__ __forceinline__ void xcd_barrier_complete(unsigned* bar, unsigned x, unsigned& nloc, unsigned& nx) {
    const unsigned G = gridDim.x * gridDim.y * gridDim.z;
    unsigned sum, cnt, mine, sp = 0u;
    for (;;) {
        sum = 0u; cnt = 0u; mine = 0u;
#pragma unroll
        for (unsigned j = 0; j < 16; ++j) { const unsigned c = xb_ld(&bar[XB_XCNT(j)]); sum += c; cnt += (c > 0u) ? 1u : 0u; mine = (j == x) ? c : mine; }
        if (sum == G) break;
        __builtin_amdgcn_s_sleep(1);
        if ((++sp & 255u) == 0u) { if (xb_ld(&bar[XB_TMO])) break; if (sp > XB_SPIN_CAP) { atomicAdd(&bar[XB_TMO], 1u); break; } }
    }
    nloc = mine > 0u ? mine : 1u; nx = cnt > 0u ? cnt : 1u;
}
__device__ __forceinline__ void xcd_barrier(const XcdBarrier& b) {
    asm volatile("s_waitcnt vmcnt(0)" ::: "memory");
    __syncthreads();
    if (b.wv == 0 && lane_now() == 0) {
        unsigned* bar = b.bar;
        __builtin_amdgcn_s_waitcnt(0);
        unsigned nloc = b.st[0], nx = b.st[1];
        if (nloc == 0u) { xcd_barrier_complete(bar, b.x, nloc, nx); b.st[0] = nloc; b.st[1] = nx; }
        const unsigned old = xb_add(&bar[XB_XSUB(b.x)], 1u);
        const unsigned gen = old / nloc;
        if (old + 1u == (gen + 1u) * nloc) {
            __builtin_amdgcn_fence(__ATOMIC_RELEASE, "agent");
            asm volatile("s_waitcnt vmcnt(0)" ::: "memory");
            const unsigned og = xb_add(&bar[XB_TOP], 1u);
            const unsigned tg = og / nx;
            if (og + 1u == (tg + 1u) * nx) xb_add(&bar[XB_TOPGEN], 1u);
            else XB_SPIN(xb_ld(&bar[XB_TOPGEN]) == tg, bar);
            __builtin_amdgcn_fence(__ATOMIC_ACQUIRE, "agent");
            xb_add(&bar[XB_XGEN(b.x)], 1u);
            asm volatile("s_waitcnt vmcnt(0)" ::: "memory");
        } else {
            XB_SPIN(xb_ld(&bar[XB_XGEN(b.x)]) == gen, bar);
            __builtin_amdgcn_fence(__ATOMIC_ACQUIRE, "agent");
            asm volatile("s_waitcnt vmcnt(0)" ::: "memory");
        }
    }
    __syncthreads();
}

namespace pg8 {
constexpr int BM = 256, BK = 64, HALF = 128, HTB = HALF * BK * 2, STAGE_BYTES = 8 * HTB;
__host__ __device__ __forceinline__ int lds_byte(int r, int c) { const int st = (r >> 4) * 2 + (c >> 5), rr = r & 15, cc = c & 31, ob = rr * 64 + cc * 2; return st * 1024 + (ob ^ (((ob >> 9) & 1) << 5)); }
__host__ __device__ __forceinline__ void stage_rc(int b, int& R, int& C) { const int st = b / 1024, sb = b % 1024, swz = sb ^ (((sb >> 9) & 1) << 5); R = (st >> 1) * 16 + swz / 64; C = (st & 1) * 32 + (swz % 64) / 2; }
__host__ __device__ __forceinline__ int perm32(int rho) { const int n = rho >> 4, i = rho & 15; return 8 * (i >> 2) + 4 * n + (i & 3); }

struct Unit { int row0, pn, e, lim; };

template <int REP> struct DenseOrderT {
    int nM, nN, nwg, G, c; int lda; const bf16_t* Bt; int ldb;
    __device__ void init(int M, int N, int G_, int c_, int lda_, const bf16_t* Bt_, int ldb_) { nM = M / BM; nN = N / BM; nwg = nM * nN; G = G_; c = c_; lda = lda_; Bt = Bt_; ldb = ldb_; }
    __device__ __forceinline__ bool next(int i, Unit& u) const {
        long L = (long)i * G + c; if (L >= (long)nwg * REP) return false; if (REP > 1) L %= nwg;
        int wgid = (int)L; { const int q = nwg / 8, r = nwg % 8, xcd = wgid % 8, off = wgid / 8; wgid = (xcd < r ? xcd * (q + 1) : r * (q + 1) + (xcd - r) * q) + off; }
        const int nig = 8 * nN, gid = wgid / nig, fm = gid * 8, gsz = (nM - fm) < 8 ? (nM - fm) : 8;
        u.row0 = (fm + ((wgid % nig) % gsz)) * BM; u.pn = (wgid % nig) / gsz; u.e = 0; u.lim = BM; return true;
    }
    static constexpr bool UNIFORM_A = true;
    __device__ __forceinline__ unsigned a_off(const Unit&, int rl, int C) const { return (unsigned)(rl * lda + C) * 2u; }
    __device__ __forceinline__ size_t a_base(const Unit& u) const { return (size_t)u.row0 * lda * 2; }
    __device__ __forceinline__ const char* b_base(const Unit& u) const { return (const char*)Bt + (size_t)u.pn * BM * ldb * 2; }
};
typedef DenseOrderT<1> DenseOrder;
struct MoeOrder {
    const LAS int* ustart; const LAS int* eoff; const LAS int* ecnt; int ntile, NP, G, c;
    const int* rowtok; int lda; const bf16_t* Bt; int ldb; size_t bstride;
    __device__ __forceinline__ bool next(int i, Unit& u) const {
        const long L = (long)i * G + c; if (L >= (long)ntile * NP) return false;
        const int tile = (int)(L / NP); u.pn = (int)(L % NP);
        const int lo = (int)((const LAS unsigned short*)(ecnt + 264))[tile];
        const int j = tile - ustart[lo];
        u.e = lo; u.row0 = eoff[lo] + BM * j; const int rem = ecnt[lo] - BM * j; u.lim = rem < BM ? rem : BM; return true;
    }
    static constexpr bool UNIFORM_A = false;
    __device__ __forceinline__ size_t a_base(const Unit&) const { return 0; }
    __device__ __forceinline__ unsigned a_off(const Unit& u, int rl, int C) const {
        const int r = u.row0 + (rl < u.lim ? rl : u.lim - 1);
        const int ar = rowtok ? rowtok[r] : r;
        return (unsigned)(ar * lda + C) * 2u;
    }
    __device__ __forceinline__ const char* b_base(const Unit& u) const { return (const char*)Bt + (size_t)u.e * bstride + (size_t)u.pn * BM * ldb * 2; }
};

template <int N> __device__ __forceinline__ void wait_vm() { asm volatile("s_waitcnt vmcnt(%0)" :: "n"(N) : "memory"); }
template <class Epi, class Sched, bool ALIGN_EPI>
__device__ __forceinline__ void gemm_phase(LAS unsigned char* lds, int tid_, const bf16_t* Abase_, int K, int ldb, const Sched& S, const Epi& E) {
    const int tid = opaque_v(tid_), wid = __builtin_amdgcn_readfirstlane(tid >> 6), lane = tid & 63, wr = wid >> 2, wc = wid & 3, fr = lane & 15, fq = lane >> 4;
    const int nt = K / BK;
    constexpr int NST = Epi::NST;
    const char* Abase = (const char*)Abase_;
    int RA[2], CA[2]; unsigned voffB[2];
#pragma unroll
    for (int i = 0; i < 2; ++i) { int R, C; stage_rc(tid * 16 + i * 8192, R, C); const int Rb = Epi::PERM ? ((R & ~31) + perm32(R & 31)) : R;
        RA[i] = R; CA[i] = C; voffB[i] = (unsigned)(Rb * ldb + C) * 2u; }
    const size_t kstep = (size_t)(BK * 2);
    const size_t hstepB = (size_t)HALF * ldb * 2;
    const unsigned ldsw = (unsigned)wid * 1024u;
    const int aoff = Epi::F8 ? lds_byte(wr * 64 + fr, fq * 16) : lds_byte(wr * 64 + fr, fq * 8), boff = Epi::F8 ? lds_byte(wc * 32 + fr, fq * 16) : lds_byte(wc * 32 + fr, fq * 8);
#define PG8_SA(b, h) (((b) * 2 + (h)) * HTB)
#define PG8_SB(b, h) ((4 + (b) * 2 + (h)) * HTB)
#define PG8_STAGE2(bufoff, gbase, o0, o1) do { \
        __builtin_amdgcn_global_load_lds((const unsigned*)((const char*)(gbase) + (unsigned)opaque_v((int)(o0))), (LAS unsigned*)(lds + (bufoff) + ldsw), 16, 0, 0); \
        __builtin_amdgcn_global_load_lds((const unsigned*)((const char*)(gbase) + (unsigned)opaque_v((int)(o1))), (LAS unsigned*)(lds + (bufoff) + ldsw + 8192), 16, 0, 0); } while (0)
#define PG8_STAGEB(bufoff, gbase) PG8_STAGE2(bufoff, gbase, voffB[0], voffB[1])
#define PG8_LD32(p) __builtin_shufflevector(*(const LAS i32x4*)(p), *(const LAS i32x4*)((p) + 16), 0, 1, 2, 3, 4, 5, 6, 7)
#define PG8_LDA(dst, b, h) do { if constexpr (Epi::F8) { _Pragma("unroll") for (int m = 0; m < 4; ++m) dst##8[m] = PG8_LD32(lds + PG8_SA(b, h) + aoff + m * 2048); } \
        else { _Pragma("unroll") for (int m = 0; m < 4; ++m) _Pragma("unroll") for (int k = 0; k < 2; ++k) dst[m][k] = *(const LAS bf16x8*)(lds + PG8_SA(b, h) + aoff + m * 2048 + k * 1024); } } while (0)
#define PG8_LDB(dst, b, h) do { if constexpr (Epi::F8) { _Pragma("unroll") for (int n = 0; n < 2; ++n) dst##8[n] = PG8_LD32(lds + PG8_SB(b, h) + boff + n * 2048); } \
        else { _Pragma("unroll") for (int n = 0; n < 2; ++n) _Pragma("unroll") for (int k = 0; k < 2; ++k) dst[n][k] = *(const LAS bf16x8*)(lds + PG8_SB(b, h) + boff + n * 2048 + k * 1024); } } while (0)
#define PG8_MMA(ai, bj, At, Bt) PG8_MMAZ(ai, bj, At, Bt, false)
#define PG8_MMAZ(ai, bj, At, Bt, Z) do { __builtin_amdgcn_s_setprio(1); \
        if constexpr (Epi::F8) { if constexpr (Z) { _Pragma("unroll") for (int m = 0; m < 4; ++m) _Pragma("unroll") for (int n = 0; n < 2; ++n) \
            asm volatile("v_mfma_scale_f32_16x16x128_f8f6f4 %0, %1, %2, 0, %3, %3 op_sel_hi:[0,0,0]" : "=&v"(acc[ai][bj][m][n]) : "v"(Bt##8[n]), "v"(At##8[m]), "v"(f8one)); } \
          else { _Pragma("unroll") for (int m = 0; m < 4; ++m) _Pragma("unroll") for (int n = 0; n < 2; ++n) \
            asm volatile("v_mfma_scale_f32_16x16x128_f8f6f4 %0, %1, %2, %0, %3, %3 op_sel_hi:[0,0,0]" : "+v"(acc[ai][bj][m][n]) : "v"(Bt##8[n]), "v"(At##8[m]), "v"(f8one)); } } \
        else { _Pragma("unroll") for (int m = 0; m < 4; ++m) _Pragma("unroll") for (int n = 0; n < 2; ++n) _Pragma("unroll") for (int k = 0; k < 2; ++k) \
            acc[ai][bj][m][n] = __builtin_amdgcn_mfma_f32_16x16x32_bf16(Bt[n][k], At[m][k], acc[ai][bj][m][n], 0, 0, 0); } \
        __builtin_amdgcn_s_setprio(0); } while (0)
#define PG8_WAIT_V(n) asm volatile("s_waitcnt vmcnt(" #n ")" ::: "memory")
#define PG8_WAIT_L(n) asm volatile("s_waitcnt lgkmcnt(" #n ")" ::: "memory")
#define PG8_BAR __builtin_amdgcn_s_barrier()
#define PG8_SCHED __builtin_amdgcn_sched_barrier(0)
    Unit cur, nxt; int ui = 0;
    if (!S.next(0, cur)) return;
    f32x4 acc[2][2][4][2];
    if constexpr (!Epi::F8) {
#pragma unroll
    for (int a = 0; a < 2; ++a)
#pragma unroll
        for (int b = 0; b < 2; ++b)
#pragma unroll
            for (int m = 0; m < 4; ++m)
#pragma unroll
                for (int n = 0; n < 2; ++n) acc[a][b][m][n] = (f32x4){0.f, 0.f, 0.f, 0.f};
    }
    bf16x8 At[4][2], B0[2][2], B1[2][2];
    int f8one = 0x7F7F7F7F; asm volatile("" : "+v"(f8one));
    i32x8 At8[4], B08[2], B18[2];
    unsigned c00 = S.a_off(cur, RA[0], CA[0]), c01 = S.a_off(cur, RA[1], CA[1]), c10 = S.a_off(cur, RA[0] + HALF, CA[0]), c11 = S.a_off(cur, RA[1] + HALF, CA[1]);
    unsigned n00 = c00, n01 = c01, n10 = c10, n11 = c11;
    const char* cA = Abase + S.a_base(cur);
    const char* cB = S.b_base(cur);
    PG8_STAGEB(PG8_SB(0, 0), cB); PG8_STAGEB(PG8_SB(0, 1), cB + hstepB); PG8_STAGE2(PG8_SA(0, 0), cA, c00, c01); PG8_STAGE2(PG8_SA(0, 1), cA, c10, c11);
    if (wr == 1) PG8_BAR;
    PG8_WAIT_V(2); PG8_BAR;
    PG8_STAGEB(PG8_SB(1, 0), cB + kstep); PG8_STAGE2(PG8_SA(1, 0), cA + kstep, c00, c01); PG8_STAGEB(PG8_SB(1, 1), cB + hstepB + kstep);
    if constexpr (NST > 0) PG8_WAIT_V(0); else PG8_WAIT_V(6);
    PG8_BAR;
    for (;;) {
        const bool has_next = S.next(ui + 1, nxt);
        const char* nB; const char* nA;
        if (has_next) { if constexpr (!Sched::UNIFORM_A) { int R0, C0, R1, C1; { const int t2 = opaque_v(tid); stage_rc(t2 * 16, R0, C0); stage_rc(t2 * 16 + 8192, R1, C1); }
                n00 = S.a_off(nxt, R0, C0); n01 = S.a_off(nxt, R1, C1); n10 = S.a_off(nxt, R0 + HALF, C0); n11 = S.a_off(nxt, R1 + HALF, C1); }
            nB = S.b_base(nxt); nA = Abase + S.a_base(nxt); }
        else { if constexpr (!Sched::UNIFORM_A) { n00 = c00; n01 = c01; n10 = c10; n11 = c11; } nB = cB; nA = cA; }
#define PG8_TRIP(ZC) do { \
            const bool last = (t == nt - 2); \
            if constexpr (Epi::MIDK) { if (t == 2 || t == 4) E.midk(acc, cur, t, wr, wc, fr, fq); } \
            const char* a1 = cA + (size_t)(t + 1) * kstep; \
            const char* a2 = last ? nA : cA + (size_t)(t + 2) * kstep; const char* b2 = last ? nB : cB + (size_t)(t + 2) * kstep; \
            const char* a3 = a2 + kstep; const char* b3 = b2 + kstep; \
            unsigned x00 = c00, x01 = c01, x10 = c10, x11 = c11; \
            if constexpr (!Sched::UNIFORM_A) { x00 = last ? n00 : c00; x01 = last ? n01 : c01; x10 = last ? n10 : c10; x11 = last ? n11 : c11; } \
            PG8_LDB(B0, 0, 0); PG8_LDB(B1, 0, 1); PG8_SCHED; PG8_LDA(At, 0, 0); PG8_STAGE2(PG8_SA(1, 1), a1, c10, c11); \
            wait_vm<8 + NST>(); PG8_WAIT_L(0); PG8_BAR; PG8_MMAZ(0, 0, At, B0, ZC); PG8_MMAZ(0, 1, At, B1, ZC); PG8_BAR; PG8_SCHED; \
            PG8_LDA(At, 0, 1); PG8_STAGEB(PG8_SB(0, 0), b2); PG8_STAGEB(PG8_SB(0, 1), b2 + hstepB); PG8_STAGE2(PG8_SA(0, 0), a2, x00, x01); \
            wait_vm<8 + NST>(); PG8_WAIT_L(0); PG8_BAR; PG8_MMAZ(1, 0, At, B0, ZC); PG8_MMAZ(1, 1, At, B1, ZC); PG8_BAR; PG8_SCHED; \
            PG8_LDB(B0, 1, 0); PG8_LDB(B1, 1, 1); PG8_SCHED; PG8_LDA(At, 1, 0); PG8_STAGE2(PG8_SA(0, 1), a2, x10, x11); \
            wait_vm<NST ? 10 + NST : 8>(); PG8_WAIT_L(0); PG8_BAR; PG8_MMA(0, 0, At, B0); PG8_MMA(0, 1, At, B1); PG8_BAR; PG8_SCHED; \
            PG8_LDA(At, 1, 1); PG8_STAGEB(PG8_SB(1, 0), b3); PG8_STAGEB(PG8_SB(1, 1), b3 + hstepB); PG8_STAGE2(PG8_SA(1, 0), a3, x00, x01); \
            PG8_WAIT_V(8); PG8_WAIT_L(0); PG8_BAR; PG8_MMA(1, 0, At, B0); PG8_MMA(1, 1, At, B1); PG8_BAR; PG8_SCHED; } while (0)
        if constexpr (Epi::F8) { const int t = 0; PG8_TRIP(true); }
#pragma unroll 1
        for (int t = Epi::F8 ? 2 : 0; t < nt; t += 2) PG8_TRIP(false);
#undef PG8_TRIP
        if constexpr (Epi::F8) asm volatile("s_nop 15\n\ts_nop 15" ::: "memory");
        if constexpr (ALIGN_EPI) { if (wr == 0) PG8_BAR; }
        E(acc, cur, wr, wc, fr, fq);
        if (!has_next) break;
        if constexpr (!Epi::F8)
#pragma unroll
        for (int a = 0; a < 2; ++a)
#pragma unroll
            for (int b = 0; b < 2; ++b)
#pragma unroll
                for (int m = 0; m < 4; ++m)
#pragma unroll
                    for (int n = 0; n < 2; ++n) acc[a][b][m][n] = (f32x4){0.f, 0.f, 0.f, 0.f};
        cur = nxt; cB = nB; cA = nA; if constexpr (!Sched::UNIFORM_A) { c00 = n00; c01 = n01; c10 = n10; c11 = n11; } ++ui;
        if constexpr (ALIGN_EPI) { if (wr == 1) PG8_BAR; }
    }
    PG8_WAIT_V(0);
    if constexpr (!ALIGN_EPI) { if (wr == 0) PG8_BAR; }
    PG8_BAR;
#undef PG8_SA
#undef PG8_SB
#undef PG8_STAGE2
#undef PG8_STAGEB
#undef PG8_LDA
#undef PG8_LDB
#undef PG8_MMA
#undef PG8_LD32
#undef PG8_WAIT_V
#undef PG8_WAIT_L
#undef PG8_BAR
#undef PG8_SCHED
}

typedef f32x4 Acc[2][2][4][2];
__device__ __forceinline__ u32x4 pack8(const f32x4 a, const f32x4 b) { u32x4 w; w.x = cvt_pk_bf16(a[0], a[1]); w.y = cvt_pk_bf16(a[2], a[3]); w.z = cvt_pk_bf16(b[0], b[1]); w.w = cvt_pk_bf16(b[2], b[3]); return w; }

__device__ __forceinline__ void rope8(f32x4& v0, f32x4& v1, int pos, int fq, const float* rc, const float* rs) {
    const int i0 = 8 * (fq & 1);
    const f32x4 c0 = *(const f32x4*)(rc + pos * 16 + i0), c1 = *(const f32x4*)(rc + pos * 16 + i0 + 4);
    f32x4 s0 = *(const f32x4*)(rs + pos * 16 + i0), s1 = *(const f32x4*)(rs + pos * 16 + i0 + 4);
    if (fq < 2) { s0 = -s0; s1 = -s1; }
    f32x4 p0, p1;
#pragma unroll
    for (int e = 0; e < 4; ++e) { p0[e] = shx(v0[e], 32); p1[e] = shx(v1[e], 32); }
    v0 = v0 * c0 + p0 * s0; v1 = v1 * c1 + p1 * s1;
}

constexpr float W8_SCALE = 32.0f;
constexpr float H8_SCALE = 8.0f;
constexpr float MIX8_SCALE = 8.0f;
__device__ __forceinline__ unsigned pack4_fp8(const f32x4 a) {
    int w = __builtin_amdgcn_cvt_pk_fp8_f32(a[0], a[1], 0, false); w = __builtin_amdgcn_cvt_pk_fp8_f32(a[2], a[3], w, true); return (unsigned)w; }
typedef short s16x2 __attribute__((ext_vector_type(2)));
__device__ __forceinline__ unsigned pack4_fp8_div(const f32x4 a, float scale) {
    s16x2 w = {0, 0}; w = __builtin_amdgcn_cvt_scalef32_pk_fp8_f32(w, a[0], a[1], scale, false); w = __builtin_amdgcn_cvt_scalef32_pk_fp8_f32(w, a[2], a[3], scale, true); return __builtin_bit_cast(unsigned, w); }
struct EpiP1 {
    static constexpr bool PERM = true, MIDK = false, F8 = true; static constexpr int NST = 0;
    bf16_t* QKV; bf16_t* DQKV; bf16_t* KR; bf16_t* GATES; float* SSQ; float* LOGF; const float* bgate; const float* bforget; const float* rc; const float* rs;
    __device__ __forceinline__ void operator()(const Acc& acc_, const Unit& u, int wr, int wc, int fr, int fq) const {
        Acc acc;
#pragma unroll
        for (int a = 0; a < 2; ++a)
#pragma unroll
            for (int b = 0; b < 2; ++b)
#pragma unroll
                for (int m = 0; m < 4; ++m)
#pragma unroll
                    for (int n = 0; n < 2; ++n) acc[a][b][m][n] = acc_[a][b][m][n] * (1.0f / W8_SCALE);
        const int pn = u.pn, row0 = u.row0 + wr * 64 + fr, lc = wc * 32 + 8 * fq;
        if (pn < 6) {
            const float sc = (pn == 0 || pn == 3) ? QS64 : 1.0f;
#pragma unroll
            for (int ai = 0; ai < 2; ++ai)
#pragma unroll
                for (int m = 0; m < 4; ++m) { bf16_t* rowp = QKV + (size_t)(row0 + ai * HALF + m * 16) * 1536 + pn * 256 + lc;
#pragma unroll
                    for (int bj = 0; bj < 2; ++bj) *(u32x4*)(rowp + bj * HALF) = pack8(acc[ai][bj][m][0] * sc, acc[ai][bj][m][1] * sc); }
        } else if (pn == 6) {
#pragma unroll
            for (int ai = 0; ai < 2; ++ai)
#pragma unroll
                for (int m = 0; m < 4; ++m) { const int row = row0 + ai * HALF + m * 16; float ss = 0.f;
#pragma unroll
                    for (int bj = 0; bj < 2; ++bj)
#pragma unroll
                        for (int n = 0; n < 2; ++n) { const f32x4 x = acc[ai][bj][m][n]; ss += (x[0] * x[0] + x[1] * x[1]) + (x[2] * x[2] + x[3] * x[3]); }
                    ss += shx(ss, 16); ss = sum32(ss);
                    if (fq == 0) SSQ[(size_t)row * 8 + wc] = ss;
#pragma unroll
                    for (int bj = 0; bj < 2; ++bj) *(u32x4*)(DQKV + (size_t)row * 512 + bj * HALF + lc) = pack8(acc[ai][bj][m][0], acc[ai][bj][m][1]); }
        } else if (pn == 7) {
#pragma unroll
            for (int ai = 0; ai < 2; ++ai)
#pragma unroll
                for (int m = 0; m < 4; ++m) { const int row = row0 + ai * HALF + m * 16; float ss = 0.f;
#pragma unroll
                    for (int n = 0; n < 2; ++n) { const f32x4 x = acc[ai][0][m][n]; ss += (x[0] * x[0] + x[1] * x[1]) + (x[2] * x[2] + x[3] * x[3]); }
                    ss += shx(ss, 16); ss = sum32(ss);
                    if (fq == 0) SSQ[(size_t)row * 8 + 4 + wc] = ss;
                    *(u32x4*)(DQKV + (size_t)row * 512 + 256 + lc) = pack8(acc[ai][0][m][0], acc[ai][0][m][1]);
                    f32x4 v0 = acc[ai][1][m][0], v1 = acc[ai][1][m][1];
                    if (wc == 0) { rope8(v0, v1, row & (SEQ - 1), fq, rc, rs); *(u32x4*)(KR + (size_t)row * 32 + 8 * fq) = pack8(v0, v1); }
                    *(u32x4*)(DQKV + (size_t)row * 512 + 384 + lc) = pack8(v0, v1);
                    if (wc == 1 && fq == 0) { f32x4 o;
#pragma unroll
                        for (int e = 0; e < 4; ++e) { const float x = acc[ai][1][m][0][e] + bforget[e]; o[e] = LOG2E * (fminf(x, 0.f) - log1pf(expf(-fabsf(x)))); }
                        *(f32x4*)(LOGF + (size_t)row * 4) = o; } }
        } else {
            const int gc0 = (pn - 8) * 256 + lc;
            f32x4 bv[2][2];
#pragma unroll
            for (int bj = 0; bj < 2; ++bj)
#pragma unroll
                for (int n = 0; n < 2; ++n) bv[bj][n] = *(const f32x4*)(bgate + gc0 + bj * HALF + 4 * n);
#pragma unroll
            for (int ai = 0; ai < 2; ++ai)
#pragma unroll
                for (int m = 0; m < 4; ++m) { bf16_t* rowp = GATES + (size_t)(row0 + ai * HALF + m * 16) * 3072 + gc0;
#pragma unroll
                    for (int bj = 0; bj < 2; ++bj) { f32x4 a = acc[ai][bj][m][0] + bv[bj][0], b = acc[ai][bj][m][1] + bv[bj][1];
#pragma unroll
                        for (int e = 0; e < 4; ++e) { a[e] = fast_sigmoid(a[e]); b[e] = fast_sigmoid(b[e]); }
                        *(u32x4*)(rowp + bj * HALF) = pack8(a, b); } }
        }
    }
};

struct EpiGate {
    static constexpr bool PERM = true, MIDK = false, F8 = true; static constexpr int STAGGER = 0; static constexpr int NST = 0;
    bf16_t* GATES; const float* bgate;
    __device__ __forceinline__ void operator()(const Acc& acc, const Unit& u, int wr, int wc, int fr, int fq) const {
        const int row0 = u.row0 + wr * 64 + fr, gc0 = u.pn * 256 + wc * 32 + 8 * fq;
        f32x4 bv[2][2];
#pragma unroll
        for (int bj = 0; bj < 2; ++bj)
#pragma unroll
            for (int n = 0; n < 2; ++n) bv[bj][n] = *(const f32x4*)(bgate + gc0 + bj * HALF + 4 * n);
#pragma unroll
        for (int ai = 0; ai < 2; ++ai)
#pragma unroll
            for (int m = 0; m < 4; ++m) { bf16_t* rowp = GATES + (size_t)(row0 + ai * HALF + m * 16) * 3072 + gc0;
#pragma unroll
                for (int bj = 0; bj < 2; ++bj) { f32x4 a = acc[ai][bj][m][0] * (1.0f / W8_SCALE) + bv[bj][0], b = acc[ai][bj][m][1] * (1.0f / W8_SCALE) + bv[bj][1];
#pragma unroll
                    for (int e = 0; e < 4; ++e) { a[e] = fast_sigmoid(a[e]); b[e] = fast_sigmoid(b[e]); }
                    *(u32x4*)(rowp + bj * HALF) = pack8(a, b); } }
    }
};
struct EpiQK {
    static constexpr bool PERM = true, MIDK = false, F8 = false; static constexpr int NST = 0;
    bf16_t* O; int ldo; const float* SSQ; float invn, scale; int rope_pn; const float* rc; const float* rs;
    __device__ __forceinline__ void operator()(const Acc& acc, const Unit& u, int wr, int wc, int fr, int fq) const {
        const int pn = u.pn, row0 = u.row0 + wr * 64 + fr, lc = wc * 32 + 8 * fq;
        f32x4 sq[2][4];
#pragma unroll
        for (int ai = 0; ai < 2; ++ai)
#pragma unroll
            for (int m = 0; m < 4; ++m) sq[ai][m] = *(const f32x4*)(SSQ + (size_t)(row0 + ai * HALF + m * 16) * 8);
#pragma unroll
        for (int ai = 0; ai < 2; ++ai)
#pragma unroll
            for (int m = 0; m < 4; ++m) { const int row = row0 + ai * HALF + m * 16; const f32x4 s4 = sq[ai][m];
                const float rsd = scale * __builtin_amdgcn_rsqf(((s4[0] + s4[1]) + (s4[2] + s4[3])) * invn + RMS_EPS);
#pragma unroll
                for (int bj = 0; bj < 2; ++bj) { f32x4 v0 = acc[ai][bj][m][0] * rsd, v1 = acc[ai][bj][m][1] * rsd;
                    if (pn == rope_pn) rope8(v0, v1, row & (SEQ - 1), fq, rc, rs);
                    *(u32x4*)(O + (size_t)row * ldo + pn * 256 + bj * HALF + lc) = pack8(v0, v1); } }
    }
};
struct EpiMix {
    static constexpr bool PERM = true, MIDK = true, F8 = true; static constexpr int NST = 0;
    bf16_t* MIXED; const bf16_t* GATES;
    __device__ __forceinline__ void midk(Acc& acc, const Unit& u, int t, int wr, int wc, int fr_, int fq_) const {
        const int fr = opaque_v(fr_), fq = opaque_v(fq_);
        const int row0 = u.row0 + wr * 64 + fr, col0 = ((t == 2) ? 0 : 1024) + u.pn * 256 + wc * 32 + 8 * fq;
#pragma unroll
        for (int ai = 0; ai < 2; ++ai)
#pragma unroll
            for (int m = 0; m < 4; ++m) { const size_t ro = (size_t)(row0 + ai * HALF + m * 16) * 3072 + col0;
#pragma unroll
                for (int bj = 0; bj < 2; ++bj) { const u32x4 ga = *(const u32x4*)(GATES + ro + bj * HALF), gb = *(const u32x4*)(GATES + ro + 1024 + bj * HALF);
                    f32x4 n0 = {bf_lo(ga.x), bf_hi(ga.x), bf_lo(ga.y), bf_hi(ga.y)}, n1 = {bf_lo(ga.z), bf_hi(ga.z), bf_lo(ga.w), bf_hi(ga.w)};
                    const f32x4 d0 = {bf_lo(gb.x), bf_hi(gb.x), bf_lo(gb.y), bf_hi(gb.y)}, d1 = {bf_lo(gb.z), bf_hi(gb.z), bf_lo(gb.w), bf_hi(gb.w)};
#pragma unroll
                    for (int e = 0; e < 4; ++e) { n0[e] *= __builtin_amdgcn_rcpf(fmaxf(d0[e], 1e-12f)); n1[e] *= __builtin_amdgcn_rcpf(fmaxf(d1[e], 1e-12f)); }
                    acc[ai][bj][m][0] = acc[ai][bj][m][0] * n0; acc[ai][bj][m][1] = acc[ai][bj][m][1] * n1; }
                if (m == 3) asm volatile("" ::: "memory"); }
    }
    __device__ __forceinline__ void operator()(const Acc& acc, const Unit& u, int wr, int wc, int fr, int fq) const {
        const int row0 = u.row0 + wr * 64 + fr, col0 = u.pn * 256 + wc * 32 + 8 * fq;
        u32x4 gv[2][4][2];
#pragma unroll
        for (int ai = 0; ai < 2; ++ai)
#pragma unroll
            for (int m = 0; m < 4; ++m)
#pragma unroll
                for (int bj = 0; bj < 2; ++bj) gv[ai][m][bj] = *(const u32x4*)(GATES + (size_t)(row0 + ai * HALF + m * 16) * 3072 + 2048 + col0 + bj * HALF);
#pragma unroll
        for (int ai = 0; ai < 2; ++ai)
#pragma unroll
            for (int m = 0; m < 4; ++m) { const size_t row = (size_t)(row0 + ai * HALF + m * 16);
#pragma unroll
                for (int bj = 0; bj < 2; ++bj) { const u32x4 g = gv[ai][m][bj];
                    const f32x4 g0 = {bf_lo(g.x), bf_hi(g.x), bf_lo(g.y), bf_hi(g.y)}, g1 = {bf_lo(g.z), bf_hi(g.z), bf_lo(g.w), bf_hi(g.w)};
                    constexpr float ms = MIX8_SCALE / (W8_SCALE * 8.0f);
                    u32x2 w; w.x = pack4_fp8(acc[ai][bj][m][0] * g0 * ms); w.y = pack4_fp8(acc[ai][bj][m][1] * g1 * ms); *(u32x2*)((unsigned char*)MIXED + row * 1024 + col0 + bj * HALF) = w; } }
    }
};
struct EpiY {
    static constexpr bool PERM = true, MIDK = false, F8 = true; static constexpr int NST = 0;
    bf16_t* Y; const float* X; const bf16_t* XH;
    __device__ __forceinline__ void operator()(const Acc& acc, const Unit& u, int wr, int wc, int fr, int fq) const {
        const int row0 = u.row0 + wr * 64 + fr, col0 = u.pn * 256 + wc * 32 + 8 * fq;
        constexpr float ds = 1.0f / (W8_SCALE * MIX8_SCALE);
#pragma unroll
        for (int ai = 0; ai < 2; ++ai) {
            f32x4 xr[4][2][2];
#pragma unroll
            for (int m = 0; m < 4; ++m) { const size_t ro = (size_t)(row0 + ai * HALF + m * 16) * 1024 + col0;
#pragma unroll
                for (int bj = 0; bj < 2; ++bj) {
                    if (X) { xr[m][bj][0] = *(const f32x4*)(X + ro + bj * HALF); xr[m][bj][1] = *(const f32x4*)(X + ro + bj * HALF + 4); }
                    else { const u32x4 w = *(const u32x4*)(XH + ro + bj * HALF); xr[m][bj][0] = (f32x4){bf_lo(w.x), bf_hi(w.x), bf_lo(w.y), bf_hi(w.y)}; xr[m][bj][1] = (f32x4){bf_lo(w.z), bf_hi(w.z), bf_lo(w.w), bf_hi(w.w)}; } } }
#pragma unroll
            for (int m = 0; m < 4; ++m) { const size_t ro = (size_t)(row0 + ai * HALF + m * 16) * 1024 + col0;
#pragma unroll
                for (int bj = 0; bj < 2; ++bj) *(u32x4*)(Y + ro + bj * HALF) = pack8(xr[m][bj][0] * DN_ALPHA + acc[ai][bj][m][0] * ds, xr[m][bj][1] * DN_ALPHA + acc[ai][bj][m][1] * ds); } }
    }
};
struct EpiF32 {
    static constexpr bool PERM = false, MIDK = false, F8 = false; static constexpr int NST = 0;
    float* C; int ldc;
    __device__ __forceinline__ void operator()(const Acc& acc, const Unit& u, int wr, int wc, int fr, int fq) const {
        const int row0 = u.row0 + wr * 64 + fr, col0 = u.pn * 256 + wc * 32 + 4 * fq;
#pragma unroll
        for (int ai = 0; ai < 2; ++ai)
#pragma unroll
            for (int m = 0; m < 4; ++m) { float* rowp = C + (size_t)(row0 + ai * HALF + m * 16) * ldc + col0;
#pragma unroll
                for (int bj = 0; bj < 2; ++bj)
#pragma unroll
                    for (int n = 0; n < 2; ++n) *(f32x4*)(rowp + bj * HALF + n * 16) = acc[ai][bj][m][n]; }
    }
};
struct EpiRouter {
    static constexpr bool PERM = false, MIDK = false, F8 = false; static constexpr int NST = 0;
    float* SCT;
    __device__ __forceinline__ void operator()(const Acc& acc, const Unit& u, int wr, int wc, int fr, int fq) const {
        const int row0 = u.row0 + wr * 64 + fr, col0 = u.pn * 256 + wc * 32 + 4 * fq;
#pragma unroll
        for (int ai = 0; ai < 2; ++ai)
#pragma unroll
            for (int m = 0; m < 4; ++m) { const int row = row0 + ai * HALF + m * 16;
#pragma unroll
                for (int bj = 0; bj < 2; ++bj)
#pragma unroll
                    for (int n = 0; n < 2; ++n)
#pragma unroll
                        for (int e = 0; e < 4; ++e) SCT[(size_t)(col0 + bj * HALF + n * 16 + e) * NTOK + row] = 1.0f / (1.0f + expf(-acc[ai][bj][m][n][e])); }
    }
};
struct EpiGU {
    static constexpr bool PERM = true, MIDK = false, F8 = true; static constexpr int NST = 0;
    bf16_t* H; const float* RW;
    __device__ __forceinline__ void operator()(const Acc& acc, const Unit& u, int wr, int wc, int fr, int fq) const {
        const int lc = u.pn * 128 + wc * 32 + 8 * fq;
        float rw[2][4];
#pragma unroll
        for (int ai = 0; ai < 2; ++ai)
#pragma unroll
            for (int m = 0; m < 4; ++m) { const int rl = ai * HALF + wr * 64 + m * 16 + fr; rw[ai][m] = RW[u.row0 + (rl < u.lim ? rl : u.lim - 1)]; }
#pragma unroll
        for (int ai = 0; ai < 2; ++ai)
#pragma unroll
            for (int m = 0; m < 4; ++m) { const int rl = ai * HALF + wr * 64 + m * 16 + fr;
                if (rl < u.lim) { const int row = u.row0 + rl; const float w = rw[ai][m]; f32x4 o[2];
#pragma unroll
                    for (int n = 0; n < 2; ++n)
#pragma unroll
                        for (int e = 0; e < 4; ++e) { const float g = acc[ai][0][m][n][e] * (1.0f / W8_SCALE); o[n][e] = g * fast_sigmoid(g) * (acc[ai][1][m][n][e] * (1.0f / W8_SCALE)) * w; }
                    u32x2 w8; w8.x = pack4_fp8(o[0] * H8_SCALE); w8.y = pack4_fp8(o[1] * H8_SCALE); *(u32x2*)((unsigned char*)H + (size_t)row * 256 + lc) = w8; } }
    }
};
constexpr float Y8_SCALE = 8.0f;
__device__ __forceinline__ f32x4 clamp_y8(f32x4 v) {
#pragma unroll
    for (int e = 0; e < 4; ++e) v[e] = __builtin_amdgcn_fmed3f(v[e] * (Y8_SCALE / (W8_SCALE * H8_SCALE)), -440.0f, 440.0f);
    return v; }
struct EpiDown {
    static constexpr bool PERM = true, MIDK = false, F8 = true; static constexpr int NST = 0;
    static constexpr float YDIV = W8_SCALE * H8_SCALE / Y8_SCALE;
    unsigned char* YS8;
    __device__ __forceinline__ void operator()(const Acc& acc, const Unit& u, int wr, int wc, int fr, int fq) const {
        const int lc = u.pn * 256 + wc * 32 + 8 * fq;
#pragma unroll
        for (int ai = 0; ai < 2; ++ai)
#pragma unroll
            for (int m = 0; m < 4; ++m) { const int rl = ai * HALF + wr * 64 + m * 16 + fr;
                if (rl < u.lim) { unsigned char* rowp = YS8 + (size_t)(u.row0 + rl) * 1024 + lc;
#pragma unroll
                    for (int bj = 0; bj < 2; ++bj) { u32x2 w; w.x = pack4_fp8_div(acc[ai][bj][m][0], YDIV); w.y = pack4_fp8_div(acc[ai][bj][m][1], YDIV); *(u32x2*)(rowp + bj * HALF) = w; } } }
    }
};
}

constexpr float OC8_SCALE = 8.0f;
struct AttnPtrs { const bf16_t* QKV; const bf16_t* QM; const bf16_t* KVM; const bf16_t* KR; const float* CUMF; unsigned char* OCAT; };
#define ATT_BAR() asm volatile("s_waitcnt lgkmcnt(0)\n\ts_barrier" ::: "memory")
__device__ __forceinline__ int crow(int i, int hh) { return (i & 3) + 8 * (i >> 2) + 4 * hh; }
__device__ __forceinline__ s16x4 vtr(const LAS unsigned char* p) { return __builtin_bit_cast(s16x4, __builtin_amdgcn_ds_read_tr16_b64_v4i16((LAS s16x4*)p)); }

template <int MODE>
__device__ __forceinline__ void attn_unit(LAS unsigned char* lds, int tid_, int b, int h, int qb, const AttnPtrs& P) {
    constexpr int DQK = (MODE == 2) ? 96 : 64, NKS = DQK / 16, KS = DQK * 2 + 16, VS = 192;
    constexpr int SLOT = 64 * KS + 64 * VS, LC = 2 * SLOT, LF = LC + 8192;
    constexpr float THR = 8.0f;
    const int wid = opaque_s(tid_), lane = lane_now(), tid = wid * 64 + lane, r = lane & 31, hh = lane >> 5;
    const size_t rowbase = (size_t)b * SEQ; const int q0 = qb * 256, qg = q0 + wid * 32 + r;
    const bf16_t* Kg; const bf16_t* Vg; int pitch;
    bf16x8 qf[NKS];
    if (MODE == 2) {
        const bf16_t* qp = P.QM + (rowbase + qg) * 768;
#pragma unroll
        for (int ks = 0; ks < 4; ++ks) qf[ks] = *(const bf16x8*)(qp + h * 64 + ks * 16 + hh * 8);
#pragma unroll
        for (int ks = 4; ks < NKS; ++ks) qf[ks] = *(const bf16x8*)(qp + 512 + h * 32 + (ks - 4) * 16 + hh * 8);
        Kg = P.KVM + rowbase * 1024 + h * 64; Vg = P.KVM + rowbase * 1024 + 512 + h * 64; pitch = 1024;
    } else {
        const int co = (MODE == 1) ? 768 : 0;
        const bf16_t* qp = P.QKV + (rowbase + qg) * 1536 + co + h * 64;
#pragma unroll
        for (int ks = 0; ks < NKS; ++ks) qf[ks] = *(const bf16x8*)(qp + ks * 16 + hh * 8);
        Kg = P.QKV + rowbase * 1536 + co + 256 + h * 64; Vg = P.QKV + rowbase * 1536 + co + 512 + h * 64; pitch = 1536;
    }
    const bf16_t* KRg = P.KR + rowbase * 32;
    float ct = 0.f;
    LAS float* ctab = (LAS float*)(lds + LC);
    if (MODE == 1) {
        const float* cf = P.CUMF + ((size_t)b * 4 + h) * SEQ;
        for (int i = tid; i < q0 + 256; i += NTHREADS) ctab[i] = cf[i];
        ct = cf[qg];
    }
    const int NT = 4 * (qb + 1);
    const int srow = tid >> 3, sch = tid & 7;
    u32x4 kreg, vreg, rreg = (u32x4){0u, 0u, 0u, 0u};
#define ATT_LDT(tt) do { const size_t gr_ = (size_t)((tt) * 64 + srow); \
        kreg = *(const u32x4*)(Kg + gr_ * pitch + sch * 8); vreg = *(const u32x4*)(Vg + gr_ * pitch + sch * 8); \
        if (MODE == 2) { if (tid < 256) rreg = *(const u32x4*)(KRg + (size_t)((tt) * 64 + (tid >> 2)) * 32 + (tid & 3) * 8); } } while (0)
#define ATT_WRT(so) do { *(LAS u32x4*)(lds + (so) + srow * KS + sch * 16) = kreg; *(LAS u32x4*)(lds + (so) + 64 * KS + srow * VS + sch * 16) = vreg; \
        if (MODE == 2) { if (tid < 256) *(LAS u32x4*)(lds + (so) + (tid >> 2) * KS + 128 + (tid & 3) * 16) = rreg; } } while (0)
    f32x16 o[2]; o[0] = f32x16{}; o[1] = f32x16{};
    float mref = 0.f, lrun = 0.f, carry = 0.f; bool wdone = false;
    const int t0 = (MODE == 0) ? NT - 1 : 0, tstep = (MODE == 0) ? -1 : 1;
    ATT_LDT(t0); ATT_WRT(0); if (NT > 1) ATT_LDT(t0 + tstep);
    ATT_BAR();
    const int vrd = (4 * hh + ((lane & 15) >> 2)) * VS + (16 * ((lane >> 4) & 1) + 4 * (lane & 3)) * 2;
    f32x16 negm;
#pragma unroll
    for (int i = 0; i < 16; ++i) negm[i] = ct;
    for (int it = 0; it < NT; ++it) {
        const int t = t0 + tstep * it; const int so = (it & 1) * SLOT;
        if (MODE == 0) {
            if (it > 0) { const LAS unsigned* fl = (const LAS unsigned*)(lds + LF) + 8 * ((it - 1) & 1); unsigned a = fl[0] & fl[1] & fl[2] & fl[3] & fl[4] & fl[5] & fl[6] & fl[7];
                if (__builtin_amdgcn_readfirstlane(a) != 0u) break; } }
        if (it + 1 < NT) { ATT_WRT(SLOT - so); if (it + 2 < NT) ATT_LDT(t + 2 * tstep); }
        const bool wskip = (MODE == 0) && ((t * 64 >= q0 + wid * 32 + 31) || wdone);
        if (!wskip) {
        f32x16 p[2];
        bf16x8 kfr[2][NKS];
#pragma unroll
        for (int kh = 0; kh < 2; ++kh)
#pragma unroll
            for (int ks = 0; ks < NKS; ++ks) kfr[kh][ks] = *(const LAS bf16x8*)(lds + so + (kh * 32 + r) * KS + (ks * 16 + hh * 8) * 2);
        s16x4 vlo[2][2][2], vhi[2][2][2];
#pragma unroll
        for (int kh = 0; kh < 2; ++kh)
#pragma unroll
            for (int s = 0; s < 2; ++s)
#pragma unroll
                for (int db = 0; db < 2; ++db) { const LAS unsigned char* va = lds + so + 64 * KS + (32 * kh + 16 * s) * VS + db * 64 + vrd; vlo[kh][s][db] = vtr(va); vhi[kh][s][db] = vtr(va + 8 * VS); }
#pragma unroll
        for (int kh = 0; kh < 2; ++kh) {
#pragma unroll
            for (int ks = 0; ks < NKS; ++ks) p[kh] = __builtin_amdgcn_mfma_f32_32x32x16_bf16(kfr[kh][ks], qf[ks], ks == 0 ? negm : p[kh], 0, 0, 0); }
        const bool band = (t * 64 + 63 >= q0 + wid * 32);
        if (MODE == 0) {
            f32x16 L[2]; float gs[8], gp[8], base[8];
#pragma unroll
            for (int kh = 0; kh < 2; ++kh)
#pragma unroll
                for (int g = 0; g < 4; ++g) { float s = 0.f;
#pragma unroll
                    for (int e = 0; e < 4; ++e) { const int i = g * 4 + e; const float z = p[kh][i];
                        float l = -(fmaxf(z, 0.f) + __builtin_amdgcn_logf(1.0f + __builtin_amdgcn_exp2f(-fabsf(z))));
                        if (band) { if (t * 64 + kh * 32 + crow(i, hh) >= qg) l = 0.f; }
                        L[kh][i] = l; s += l; }
                    gs[kh * 4 + g] = s; }
#pragma unroll
            for (int m = 0; m < 8; ++m) gp[m] = shx(gs[m], 32);
            float T = carry;
#pragma unroll
            for (int m = 7; m >= 0; --m) { base[m] = T + (hh == 0 ? gp[m] : 0.f); T += gs[m] + gp[m]; }
            carry = T;
#pragma unroll
            for (int kh = 0; kh < 2; ++kh)
#pragma unroll
                for (int g = 0; g < 4; ++g) { float E = base[kh * 4 + g];
#pragma unroll
                    for (int e = 3; e >= 0; --e) { const int i = g * 4 + e; const float l = L[kh][i];
                        float w = __builtin_amdgcn_exp2f(p[kh][i] + l + E);
                        if (band) { if (t * 64 + kh * 32 + crow(i, hh) >= qg) w = 0.f; }
                        p[kh][i] = w; E += l; } }
            wdone = __all(carry < -48.0f);
        } else {
            if (MODE == 1) {
#pragma unroll
                for (int kh = 0; kh < 2; ++kh)
#pragma unroll
                    for (int g = 0; g < 4; ++g) { const f32x4 c4 = *(const LAS f32x4*)(ctab + t * 64 + kh * 32 + 8 * g + 4 * hh);
#pragma unroll
                        for (int e = 0; e < 4; ++e) { const int i = g * 4 + e; p[kh][i] -= c4[e]; } }
                if (band) {
                    asm volatile("" ::: "memory");
#pragma unroll
                    for (int kh = 0; kh < 2; ++kh)
#pragma unroll
                        for (int i = 0; i < 16; ++i) { if (t * 64 + kh * 32 + crow(i, hh) > qg) p[kh][i] = -INFINITY; } }
            } else {
                if (band && t > (qg >> 6)) {
                    asm volatile("" ::: "memory");
#pragma unroll
                    for (int kh = 0; kh < 2; ++kh)
#pragma unroll
                        for (int i = 0; i < 16; ++i) p[kh][i] = -INFINITY; }
            }
            float mx = fmaxf(fmaxf(p[0][0], p[1][0]), p[0][1]);
#pragma unroll
            for (int i = 1; i < 16; ++i) mx = fmaxf(fmaxf(mx, p[0][i]), p[1][i]);
            mx = max32(mx);
            if (it == 0 || __any(mx > THR)) {
                const float d = (it == 0) ? mx : fmaxf(mx, 0.f), f = (it == 0) ? 1.0f : __builtin_amdgcn_exp2f(-d);
                mref += d; lrun *= f; o[0] = o[0] * f; o[1] = o[1] * f;
#pragma unroll
                for (int kh = 0; kh < 2; ++kh)
#pragma unroll
                    for (int i = 0; i < 16; ++i) p[kh][i] -= d;
#pragma unroll
                for (int i = 0; i < 16; ++i) negm[i] = ct - mref;
            }
            float ps = 0.f;
#pragma unroll
            for (int kh = 0; kh < 2; ++kh)
#pragma unroll
                for (int i = 0; i < 16; ++i) { const float e = __builtin_amdgcn_exp2f(p[kh][i]); p[kh][i] = e; ps += e; }
            lrun += ps;
        }
#pragma unroll
        for (int kh = 0; kh < 2; ++kh)
#pragma unroll
            for (int s = 0; s < 2; ++s) {
                u32x4 pw; pw.x = cvt_pk_bf16(p[kh][8 * s + 0], p[kh][8 * s + 1]); pw.y = cvt_pk_bf16(p[kh][8 * s + 2], p[kh][8 * s + 3]);
                pw.z = cvt_pk_bf16(p[kh][8 * s + 4], p[kh][8 * s + 5]); pw.w = cvt_pk_bf16(p[kh][8 * s + 6], p[kh][8 * s + 7]);
                const bf16x8 pb = __builtin_bit_cast(bf16x8, pw);
#pragma unroll
                for (int db = 0; db < 2; ++db) {
                    const s16x4 lo = vlo[kh][s][db], hi = vhi[kh][s][db];
                    const bf16x8 vf = (bf16x8){lo[0], lo[1], lo[2], lo[3], hi[0], hi[1], hi[2], hi[3]};
                    o[db] = __builtin_amdgcn_mfma_f32_32x32x16_bf16(vf, pb, o[db], 0, 0, 0); } }
        }
        if (MODE == 0) { if (lane == 0) ((LAS unsigned*)(lds + LF))[8 * (it & 1) + wid] = wdone ? 1u : 0u; }
        ATT_BAR();
    }
    if (MODE != 0) { const float lt = sum32(lrun); const float inv = 1.0f / lt; o[0] = o[0] * inv; o[1] = o[1] * inv; }
    unsigned char* op = P.OCAT + (rowbase + qg) * 1024 + ((MODE == 0) ? 0 : (MODE == 1) ? 256 : 512) + h * 64;
#pragma unroll
    for (int db = 0; db < 2; ++db)
#pragma unroll
        for (int g = 0; g < 4; ++g) { const f32x4 v4 = {o[db][4 * g + 0] * OC8_SCALE, o[db][4 * g + 1] * OC8_SCALE, o[db][4 * g + 2] * OC8_SCALE, o[db][4 * g + 3] * OC8_SCALE};
            *(unsigned*)(op + db * 32 + 8 * g + 4 * hh) = pg8::pack4_fp8(v4); }
#undef ATT_LDT
#undef ATT_WRT
}

template <int MODE>
__device__ __forceinline__ void attn_unit_sm(LAS unsigned char* lds, int tid_, int b, int h, int qb, const AttnPtrs& P) {
    constexpr int DQK = (MODE == 2) ? 96 : 64, NKS = DQK / 16, KS = DQK * 2 + 16, VS = 192;
    constexpr int SLOT = 64 * KS + 64 * VS, LC = 3 * SLOT;
    constexpr float THR = 8.0f;
    const int wid = opaque_s(tid_), lane = lane_now(), tid = wid * 64 + lane, r = lane & 31, hh = lane >> 5;
    const size_t rowbase = (size_t)b * SEQ; const int q0 = qb * 256, qg = q0 + wid * 32 + r;
    const bf16_t* Kg; const bf16_t* Vg; int pitch;
    bf16x8 qf[NKS];
    if (MODE == 2) {
        const bf16_t* qp = P.QM + (rowbase + qg) * 768;
#pragma unroll
        for (int ks = 0; ks < 4; ++ks) qf[ks] = *(const bf16x8*)(qp + h * 64 + ks * 16 + hh * 8);
#pragma unroll
        for (int ks = 4; ks < NKS; ++ks) qf[ks] = *(const bf16x8*)(qp + 512 + h * 32 + (ks - 4) * 16 + hh * 8);
        Kg = P.KVM + rowbase * 1024 + h * 64; Vg = P.KVM + rowbase * 1024 + 512 + h * 64; pitch = 1024;
    } else {
        const bf16_t* qp = P.QKV + (rowbase + qg) * 1536 + 768 + h * 64;
#pragma unroll
        for (int ks = 0; ks < NKS; ++ks) qf[ks] = *(const bf16x8*)(qp + ks * 16 + hh * 8);
        Kg = P.QKV + rowbase * 1536 + 768 + 256 + h * 64; Vg = P.QKV + rowbase * 1536 + 768 + 512 + h * 64; pitch = 1536;
    }
    const bf16_t* KRg = P.KR + rowbase * 32;
    float ct = 0.f;
    LAS float* ctab = (LAS float*)(lds + LC);
    if (MODE == 1) {
        const float* cf = P.CUMF + ((size_t)b * 4 + h) * SEQ;
        for (int i = tid; i < q0 + 256; i += NTHREADS) ctab[i] = cf[i];
        ct = cf[qg];
    }
    const int NT = 4 * (qb + 1);
    const int cw = (q0 + wid * 32 + 31) >> 6;
    const int srow = tid >> 3, sch = tid & 7;
    u32x4 kreg, vreg, rreg = (u32x4){0u, 0u, 0u, 0u};
#define ATT_LDT(tt) do { const size_t gr_ = (size_t)((tt) * 64 + srow); \
        kreg = *(const u32x4*)(Kg + gr_ * pitch + sch * 8); vreg = *(const u32x4*)(Vg + gr_ * pitch + sch * 8); \
        if (MODE == 2) { if (tid < 256) rreg = *(const u32x4*)(KRg + (size_t)((tt) * 64 + (tid >> 2)) * 32 + (tid & 3) * 8); } } while (0)
#define ATT_WRT(so) do { *(LAS u32x4*)(lds + (so) + srow * KS + sch * 16) = kreg; *(LAS u32x4*)(lds + (so) + 64 * KS + srow * VS + sch * 16) = vreg; \
        if (MODE == 2) { if (tid < 256) *(LAS u32x4*)(lds + (so) + (tid >> 2) * KS + 128 + (tid & 3) * 16) = rreg; } } while (0)
#define ATT_QK(dst, so) do { bf16x8 kfr_[2][NKS]; \
        _Pragma("unroll") for (int kh = 0; kh < 2; ++kh) _Pragma("unroll") for (int ks = 0; ks < NKS; ++ks) kfr_[kh][ks] = *(const LAS bf16x8*)(lds + (so) + (kh * 32 + r) * KS + (ks * 16 + hh * 8) * 2); \
        _Pragma("unroll") for (int kh = 0; kh < 2; ++kh) _Pragma("unroll") for (int ks = 0; ks < NKS; ++ks) dst[kh] = __builtin_amdgcn_mfma_f32_32x32x16_bf16(kfr_[kh][ks], qf[ks], ks == 0 ? negm : dst[kh], 0, 0, 0); } while (0)
    f32x16 o[2]; o[0] = f32x16{}; o[1] = f32x16{};
    float mref = 0.f;
    f32x16 negm;
#pragma unroll
    for (int i = 0; i < 16; ++i) negm[i] = ct;
    ATT_LDT(0); ATT_WRT(0); ATT_LDT(1); ATT_WRT(SLOT); ATT_LDT(2);
    ATT_BAR();
    const int vrd = (4 * hh + ((lane & 15) >> 2)) * VS + (16 * ((lane >> 4) & 1) + 4 * (lane & 3)) * 2;
    f32x16 pa[2], pb2[2];
    f32x16 o2 = f32x16{};
    const bf16x8 ones = (bf16x8){(short)0x3F80, (short)0x3F80, (short)0x3F80, (short)0x3F80, (short)0x3F80, (short)0x3F80, (short)0x3F80, (short)0x3F80};
    ATT_QK(pa, 0);
    int sc = 0, sn = SLOT, sw = 2 * SLOT;
#define ATT_STEP(PC, PN, t) do { \
        if ((t) + 2 < NT) { ATT_WRT(sw); if ((t) + 3 < NT) ATT_LDT((t) + 3); } \
        if ((t) <= cw) { \
            if ((t) + 1 <= cw && (t) + 1 < NT) ATT_QK(PN, sn); \
            s16x4 vlo[2][2][2], vhi[2][2][2]; \
            _Pragma("unroll") for (int kh = 0; kh < 2; ++kh) _Pragma("unroll") for (int s = 0; s < 2; ++s) _Pragma("unroll") for (int db = 0; db < 2; ++db) { \
                const LAS unsigned char* va = lds + sc + 64 * KS + (32 * kh + 16 * s) * VS + db * 64 + vrd; vlo[kh][s][db] = vtr(va); vhi[kh][s][db] = vtr(va + 8 * VS); } \
            const bool band = ((t) * 64 + 63 >= q0 + wid * 32); \
            if (MODE == 1) { \
                _Pragma("unroll") for (int kh = 0; kh < 2; ++kh) _Pragma("unroll") for (int g = 0; g < 4; ++g) { const f32x4 c4 = *(const LAS f32x4*)(ctab + (t) * 64 + kh * 32 + 8 * g + 4 * hh); \
                    _Pragma("unroll") for (int e = 0; e < 4; ++e) PC[kh][g * 4 + e] -= c4[e]; } \
                if (band) { asm volatile("" ::: "memory"); \
                    _Pragma("unroll") for (int kh = 0; kh < 2; ++kh) _Pragma("unroll") for (int i = 0; i < 16; ++i) { if ((t) * 64 + kh * 32 + crow(i, hh) > qg) PC[kh][i] = -INFINITY; } } \
            } \
            float mx = fmaxf(fmaxf(PC[0][0], PC[1][0]), PC[0][1]); \
            _Pragma("unroll") for (int i = 1; i < 16; ++i) mx = fmaxf(fmaxf(mx, PC[0][i]), PC[1][i]); \
            mx = max32(mx); \
            if ((t) == 0 || __any(mx > THR)) { \
                const float d = ((t) == 0) ? mx : fmaxf(mx, 0.f), f = ((t) == 0) ? 1.0f : __builtin_amdgcn_exp2f(-d); \
                mref += d; o2 = o2 * f; o[0] = o[0] * f; o[1] = o[1] * f; \
                _Pragma("unroll") for (int kh = 0; kh < 2; ++kh) _Pragma("unroll") for (int i = 0; i < 16; ++i) { PC[kh][i] -= d; PN[kh][i] -= d; } \
                _Pragma("unroll") for (int i = 0; i < 16; ++i) negm[i] = ct - mref; \
            } \
            _Pragma("unroll") for (int kh = 0; kh < 2; ++kh) _Pragma("unroll") for (int i = 0; i < 16; ++i) PC[kh][i] = __builtin_amdgcn_exp2f(PC[kh][i]); \
            _Pragma("unroll") for (int kh = 0; kh < 2; ++kh) _Pragma("unroll") for (int s = 0; s < 2; ++s) { \
                u32x4 pw; pw.x = cvt_pk_bf16(PC[kh][8 * s + 0], PC[kh][8 * s + 1]); pw.y = cvt_pk_bf16(PC[kh][8 * s + 2], PC[kh][8 * s + 3]); \
                pw.z = cvt_pk_bf16(PC[kh][8 * s + 4], PC[kh][8 * s + 5]); pw.w = cvt_pk_bf16(PC[kh][8 * s + 6], PC[kh][8 * s + 7]); \
                const bf16x8 pb = __builtin_bit_cast(bf16x8, pw); \
                o2 = __builtin_amdgcn_mfma_f32_32x32x16_bf16(ones, pb, o2, 0, 0, 0); \
                _Pragma("unroll") for (int db = 0; db < 2; ++db) { const s16x4 lo = vlo[kh][s][db], hi = vhi[kh][s][db]; \
                    const bf16x8 vf = (bf16x8){lo[0], lo[1], lo[2], lo[3], hi[0], hi[1], hi[2], hi[3]}; \
                    o[db] = __builtin_amdgcn_mfma_f32_32x32x16_bf16(vf, pb, o[db], 0, 0, 0); } } \
        } \
        ATT_BAR(); \
        { const int tmp_ = sc; sc = sn; sn = sw; sw = tmp_; } } while (0)
    for (int t = 0; t < NT; t += 2) { ATT_STEP(pa, pb2, t); ATT_STEP(pb2, pa, t + 1); }
#undef ATT_STEP
    { const float inv = 1.0f / o2[0]; o[0] = o[0] * inv; o[1] = o[1] * inv; }
    unsigned char* op = P.OCAT + (rowbase + qg) * 1024 + ((MODE == 1) ? 256 : 512) + h * 64;
#pragma unroll
    for (int db = 0; db < 2; ++db)
#pragma unroll
        for (int g = 0; g < 4; ++g) { const f32x4 v4 = {o[db][4 * g + 0] * OC8_SCALE, o[db][4 * g + 1] * OC8_SCALE, o[db][4 * g + 2] * OC8_SCALE, o[db][4 * g + 3] * OC8_SCALE};
            *(unsigned*)(op + db * 32 + 8 * g + 4 * hh) = pg8::pack4_fp8(v4); }
#undef ATT_LDT
#undef ATT_WRT
#undef ATT_QK
}

__device__ __forceinline__ void attn_item(LAS unsigned char* lds, int tid_, const AttnPtrs& P, int item, int k) {
    if (item < 256) { const int bh = item >> 2, s = item & 3; attn_unit<0>(lds, tid_, bh >> 2, bh & 3, k ? s : 7 - s, P); }
    else if (item < 512) { const int j = item - 256, bh = j >> 2, s = j & 3; attn_unit_sm<1>(lds, tid_, bh >> 2, bh & 3, k ? s : 7 - s, P); }
    else { const int j = item - 512, bh = j >> 2, s = j & 3; attn_unit_sm<2>(lds, tid_, bh >> 3, bh & 7, k ? s : 7 - s, P); }
}

struct Frame { LAS unsigned char* lds; int tid, lane, wave, vcu, G, gw, NGW; };
typedef const __attribute__((address_space(4))) unsigned char* kargp_t;
__device__ __forceinline__ kargp_t karg_base() { kargp_t p = (kargp_t)__builtin_amdgcn_kernarg_segment_ptr(); asm volatile("" : "+s"(p)); return p; }
__device__ __forceinline__ const float* karg_in(kargp_t kp, int i) { return *(const float* const __attribute__((address_space(4)))*)(kp + 8 * i); }
__device__ __forceinline__ float* karg_out(kargp_t kp) { return *(float* const __attribute__((address_space(4)))*)(kp + 192); }
__device__ __forceinline__ unsigned char* karg_ws(kargp_t kp) { return *(unsigned char* const __attribute__((address_space(4)))*)(kp + 200); }
#define LDS_WAIT() asm volatile("s_waitcnt lgkmcnt(0)" ::: "memory")

__device__ __forceinline__ int srccol(int mode, int n) {
    switch (mode) {
    case 1:
        if (n < 1536) return n;
        if (n < 1792) return OFF_DQ + (n - 1536);
        if (n < 1920) return OFF_DKV + (n - 1792);
        if (n < 1952) return OFF_KR + (n - 1920);
        if (n < 1956) return OFF_FGATE + (n - 1952);
        if (n < 2048) return -1;
        return OFF_GATE + (n - 2048);
    case 2:
        if (n < 512) return (n >> 6) * 96 + (n & 63);
        return ((n - 512) >> 5) * 96 + 64 + ((n - 512) & 31);
    case 3:
        if (n < 512) return (n >> 6) * 128 + (n & 63);
        return ((n - 512) >> 6) * 128 + 64 + ((n - 512) & 63);
    case 6: return OFF_GATE + n;
    case 4:
        return 128 * (n >> 8) + (n & 127);
    default: return n;
    }
}
struct TJob { const float* src; const float* src2; int ldw, Ksrc, K, Nd, mode; const float* kscale; bf16_t* dst; int dld; int f8; };
__device__ __forceinline__ void titem_load(const TJob& J, int item, int lane, float (&v)[32]) {
    const int nblk = J.Nd / 32, kb = item / nblk, nb = item % nblk, k0 = 64 * kb, n0 = 32 * nb;
    const int n = n0 + (lane & 31); const int sc = srccol(J.mode, n);
    const float* S = (J.mode == 4 && ((n >> 7) & 1)) ? J.src2 : J.src;
#pragma unroll
    for (int i = 0; i < 32; ++i) { const int k = k0 + 2 * i + (lane >> 5); v[i] = (sc >= 0 && k < J.Ksrc) ? __builtin_nontemporal_load(S + (size_t)k * J.ldw + sc) : 0.f; }
}
__device__ __forceinline__ void titem_load4(const TJob& J, int item, int lane, float (&v)[32]) {
    const int nblk = J.Nd / 32, kb = item / nblk, nb = item % nblk, k0 = 64 * kb, n0 = 32 * nb;
    const int n = n0 + 4 * (lane & 7); const int sc = srccol(J.mode, n);
    const float* S = (J.mode == 4 && ((n >> 7) & 1)) ? J.src2 : J.src;
#pragma unroll
    for (int i = 0; i < 8; ++i) { const f32x4 q = __builtin_nontemporal_load((const f32x4*)(S + (size_t)(k0 + 8 * i + (lane >> 3)) * J.ldw + sc));
        v[4 * i + 0] = q[0]; v[4 * i + 1] = q[1]; v[4 * i + 2] = q[2]; v[4 * i + 3] = q[3]; }
}
template <bool X4 = false>
__device__ __forceinline__ void titem_store(const TJob& J, LAS float* scr, int item, int lane, float (&v)[32]) {
    const int nblk = J.Nd / 32, kb = item / nblk, nb = item % nblk, k0 = 64 * kb, n0 = 32 * nb;
    if (!X4 && J.kscale) {
#pragma unroll
        for (int i = 0; i < 32; ++i) { const int k = k0 + 2 * i + (lane >> 5); if (k < J.Ksrc) v[i] *= J.kscale[k]; } }
    if constexpr (X4) {
#pragma unroll
        for (int i = 0; i < 8; ++i)
#pragma unroll
            for (int e = 0; e < 4; ++e) scr[(8 * i + (lane >> 3)) * 33 + 4 * (lane & 7) + e] = v[4 * i + e];
    } else
#pragma unroll
    for (int i = 0; i < 32; ++i) scr[(2 * i + (lane >> 5)) * 33 + (lane & 31)] = v[i];
    LDS_WAIT(); asm volatile("" ::: "memory");
    if (J.f8) {
        const int c4 = lane & 3;
#pragma unroll
        for (int j = 0; j < 2; ++j) { const int nn = (lane >> 2) + 16 * j; const LAS float* s = scr + (16 * c4) * 33 + nn; u32x4 o;
#pragma unroll
            for (int q = 0; q < 4; ++q) { int w = __builtin_amdgcn_cvt_pk_fp8_f32(s[(4 * q + 0) * 33] * 32.0f, s[(4 * q + 1) * 33] * 32.0f, 0, false);
                w = __builtin_amdgcn_cvt_pk_fp8_f32(s[(4 * q + 2) * 33] * 32.0f, s[(4 * q + 3) * 33] * 32.0f, w, true); o[q] = (unsigned)w; }
            *(u32x4*)((unsigned char*)J.dst + (size_t)(n0 + nn) * J.dld + k0 + 16 * c4) = o; }
        LDS_WAIT(); asm volatile("" ::: "memory"); return; }
    const int c = lane & 7;
#pragma unroll
    for (int j = 0; j < 4; ++j) { const int nn = (lane >> 3) + 8 * j; const LAS float* s = scr + (8 * c) * 33 + nn;
        u32x4 o; o.x = cvt_pk_bf16(s[0 * 33], s[1 * 33]); o.y = cvt_pk_bf16(s[2 * 33], s[3 * 33]); o.z = cvt_pk_bf16(s[4 * 33], s[5 * 33]); o.w = cvt_pk_bf16(s[6 * 33], s[7 * 33]);
        *(u32x4*)(J.dst + (size_t)(n0 + nn) * J.dld + k0 + 8 * c) = o; }
    LDS_WAIT(); asm volatile("" ::: "memory");
}
__device__ __forceinline__ void transpose_item(const TJob& J, LAS float* scr, int item, int lane) { float v[32]; titem_load(J, item, lane, v); titem_store(J, scr, item, lane, v); }
__device__ __forceinline__ void run_job(const Frame& F, const TJob& J) {
    LAS float* scr = (LAS float*)(F.lds + F.wave * 16384);
    const int nitems = (J.K / 64) * (J.Nd / 32);
    for (int it = F.gw; it < nitems; it += F.NGW) transpose_item(J, scr, it, F.lane);
}
__device__ __forceinline__ void convert_small_weights(const Frame& F, kargp_t kp, unsigned char* ws, int l) {
    unsigned char* wb = ws + WS_WSMALL + (size_t)l * WSMALL_LAYER;
    TJob J;
    J.src2 = nullptr; J.kscale = nullptr; J.f8 = 0;
    J.src = karg_in(kp, 5) + (size_t)l * DM * IN_WIDTH; J.ldw = IN_WIDTH; J.Ksrc = 1024; J.K = 1024; J.Nd = 2048; J.mode = 1; J.dst = (bf16_t*)(wb + WOF_IN); J.dld = 1024; J.f8 = 1; run_job(F, J); J.f8 = 0;
    J.Nd = 3072; J.mode = 6; J.dst = (bf16_t*)(wb + WOF_IN + 4 * MiB); J.f8 = 1; run_job(F, J); J.f8 = 0;
    J.src = karg_in(kp, 9) + (size_t)l * 256 * 768; J.ldw = 768; J.Ksrc = 256; J.K = 256; J.Nd = 768; J.mode = 2; J.kscale = karg_in(kp, 8) + l * 256; J.dst = (bf16_t*)(wb + WOF_UQ); J.dld = 256; run_job(F, J);
    J.src = karg_in(kp, 11) + (size_t)l * 128 * 1024; J.ldw = 1024; J.Ksrc = 128; J.K = 256; J.Nd = 1024; J.mode = 3; J.kscale = karg_in(kp, 10) + l * 128; J.dst = (bf16_t*)(wb + WOF_UKV); J.dld = 256; run_job(F, J);
    J.kscale = nullptr; J.mode = 0;
    J.f8 = 1;
    J.src = karg_in(kp, 12) + (size_t)l * 256 * 1024; J.ldw = 1024; J.Ksrc = 256; J.K = 256; J.Nd = 1024; J.dst = (bf16_t*)(wb + WOF_PSB); J.dld = 1024; run_job(F, J);
    J.src = karg_in(kp, 13) + (size_t)l * 256 * 1024; J.dst = (bf16_t*)(wb + WOF_PSB + 256); run_job(F, J);
    J.src = karg_in(kp, 14) + (size_t)l * 512 * 1024; J.Ksrc = 512; J.K = 512; J.dst = (bf16_t*)(wb + WOF_PSB + 512); run_job(F, J);
    J.f8 = 0;
    J.src = karg_in(kp, 15) + (size_t)l * 1024 * 1024; J.Ksrc = 1024; J.K = 1024; J.dst = (bf16_t*)(wb + WOF_OUT3); J.dld = 1024; J.f8 = 1; run_job(F, J); J.f8 = 0;
    J.src = karg_in(kp, 16) + (size_t)l * 1024 * 256; J.ldw = 256; J.Nd = 256; J.dst = (bf16_t*)(wb + WOF_R); J.dld = 1024; run_job(F, J);
}
__device__ __forceinline__ void expert_job(kargp_t kp, unsigned char* ws, int l, int it, TJob& J, int& sub) {
    if (it < NE1 * 256) { const int e = it >> 8; sub = it & 255;
        if (e < NEXP) { J.src = karg_in(kp, 18) + ((size_t)l * NEXP + e) * 1024 * 256; J.src2 = karg_in(kp, 19) + ((size_t)l * NEXP + e) * 1024 * 256; }
        else { J.src = karg_in(kp, 21) + (size_t)l * 1024 * 256; J.src2 = karg_in(kp, 22) + (size_t)l * 1024 * 256; }
        J.ldw = 256; J.Ksrc = 1024; J.K = 1024; J.Nd = 512; J.mode = 4; J.kscale = nullptr; J.dst = (bf16_t*)(ws + WS_WGU + (size_t)e * 512 * 1024); J.dld = 1024; J.f8 = 1;
    } else { const int q = it - NE1 * 256, e = q >> 7; sub = q & 127;
        J.src = (e < NEXP) ? karg_in(kp, 20) + ((size_t)l * NEXP + e) * 256 * 1024 : karg_in(kp, 23) + (size_t)l * 256 * 1024; J.src2 = nullptr;
        J.ldw = 1024; J.Ksrc = 256; J.K = 256; J.Nd = 1024; J.mode = 0; J.kscale = nullptr; J.dst = (bf16_t*)(ws + WS_WD + (size_t)e * 1024 * 256); J.dld = 256; J.f8 = 1; }
}
__device__ __forceinline__ void convert_expert_weights(const Frame& F, kargp_t kp, unsigned char* ws, int l) {
    LAS float* scr = (LAS float*)(F.lds + F.wave * 16384);
    constexpr int NIT = NE1 * 256 + NE1 * 128;
    float va[32], vb[32]; TJob Ja, Jb; int sa = 0, sb = 0; int it = F.gw;
    if (it < NIT) { expert_job(kp, ws, l, it, Ja, sa); titem_load4(Ja, sa, F.lane, va); }
    while (it < NIT) {
        const int itn = it + F.NGW; const bool hn = itn < NIT;
        if (hn) { expert_job(kp, ws, l, itn, Jb, sb); titem_load4(Jb, sb, F.lane, vb); }
        titem_store<true>(Ja, scr, sa, F.lane, va);
        if (hn) { Ja = Jb; sa = sb;
#pragma unroll
            for (int i = 0; i < 32; ++i) va[i] = vb[i]; }
        it = itn;
    }
}
__device__ __forceinline__ void build_rope(const Frame& F, unsigned char* ws) {
    float* rc = (float*)(ws + WS_ROPE); float* rs = rc + SEQ * 16;
    for (int idx = F.gw * 64 + F.lane; idx < SEQ * 16; idx += F.NGW * 64) { const int pos = idx >> 4, i = idx & 15;
        const float inv = exp2f(-(float)i * (13.287712379549449f / 16.0f));
        const float ang = (float)pos * inv;
        double rev = (double)ang * 0.15915494309189535; rev -= floor(rev);
        rc[idx] = __builtin_amdgcn_cosf((float)rev); rs[idx] = __builtin_amdgcn_sinf((float)rev); }
}
__device__ __forceinline__ void convert_x(const Frame& F, const float* x, bf16_t* xb, unsigned char* x8) {
    for (size_t i = (size_t)F.gw * 64 + F.lane; i < (size_t)NTOK * DM / 8; i += (size_t)F.NGW * 64) {
        const f32x4 a = *(const f32x4*)(x + i * 8), b = *(const f32x4*)(x + i * 8 + 4);
        *(u32x4*)(xb + i * 8) = pg8::pack8(a, b); u32x2 w8; w8.x = pg8::pack4_fp8(a); w8.y = pg8::pack4_fp8(b); *(u32x2*)(x8 + i * 8) = w8; }
}
__device__ __forceinline__ void cumf_phase(const Frame& F, unsigned char* ws) {
    const float* LOGF = (const float*)(ws + WS_LOGF); float* CUMF = (float*)(ws + WS_CUMF);
    for (int seq = F.gw; seq < NBATCH * 4; seq += F.NGW) { const int b = seq >> 2, h = seq & 3;
        float v[32]; float s = 0.f;
#pragma unroll
        for (int j = 0; j < 32; ++j) { s += LOGF[((size_t)b * SEQ + F.lane * 32 + j) * 4 + h]; v[j] = s; }
        float inc = s;
#pragma unroll
        for (int o = 1; o < 64; o <<= 1) { const float u = shup(inc, o); if (F.lane >= o) inc += u; }
        const float ex = inc - s;
#pragma unroll
        for (int j = 0; j < 32; ++j) CUMF[(size_t)seq * SEQ + F.lane * 32 + j] = v[j] + ex; }
}
__device__ __forceinline__ void ln_store(const Frame& F, f32x4 (&v)[4], const float* g, const float* bb, float* orow, bf16_t* obrow, unsigned char* o8row = nullptr) {
    float s = 0.f;
#pragma unroll
    for (int j = 0; j < 4; ++j) s += (v[j][0] + v[j][1]) + (v[j][2] + v[j][3]);
    const float mean = wave_sum(s) * (1.0f / DM); float s2 = 0.f;
#pragma unroll
    for (int j = 0; j < 4; ++j) { v[j] = v[j] - mean; s2 += (v[j][0] * v[j][0] + v[j][1] * v[j][1]) + (v[j][2] * v[j][2] + v[j][3] * v[j][3]); }
    const float rstd = 1.0f / sqrtf(wave_sum(s2) * (1.0f / DM) + LN_EPS);
#pragma unroll
    for (int j = 0; j < 4; ++j) { const int c = 256 * j + 4 * F.lane; const f32x4 gv = *(const f32x4*)(g + c), bv = *(const f32x4*)(bb + c);
        const f32x4 y = v[j] * rstd * gv + bv; if (orow) *(f32x4*)(orow + c) = y;
        if (obrow) { u32x2 w; w.x = cvt_pk_bf16(y[0], y[1]); w.y = cvt_pk_bf16(y[2], y[3]); *(u32x2*)(obrow + c) = w; }
        if (o8row) *(unsigned*)(o8row + c) = pg8::pack4_fp8(y); }
}
__device__ __forceinline__ void ln1_phase(const Frame& F, const bf16_t* Y, const float* g, const float* bb, float* STATS, bf16_t* X1B, unsigned char* X1F8) {
    f32x4 gv[2][2], bv[2][2];
#pragma unroll
    for (int j = 0; j < 2; ++j)
#pragma unroll
        for (int q = 0; q < 2; ++q) { gv[j][q] = *(const f32x4*)(g + 512 * j + 8 * F.lane + 4 * q); bv[j][q] = *(const f32x4*)(bb + 512 * j + 8 * F.lane + 4 * q); }
    for (int r0 = F.gw * 4; r0 < NTOK; r0 += F.NGW * 4) {
        u32x4 w[4][2];
#pragma unroll
        for (int k = 0; k < 4; ++k)
#pragma unroll
            for (int j = 0; j < 2; ++j) w[k][j] = *(const u32x4*)(Y + (size_t)(r0 + k) * DM + 512 * j + 8 * F.lane);
#pragma unroll
        for (int k = 0; k < 4; ++k) { f32x4 v[2][2]; float s = 0.f;
#pragma unroll
            for (int j = 0; j < 2; ++j) { v[j][0] = (f32x4){bf_lo(w[k][j].x), bf_hi(w[k][j].x), bf_lo(w[k][j].y), bf_hi(w[k][j].y)}; v[j][1] = (f32x4){bf_lo(w[k][j].z), bf_hi(w[k][j].z), bf_lo(w[k][j].w), bf_hi(w[k][j].w)};
                s += ((v[j][0][0] + v[j][0][1]) + (v[j][0][2] + v[j][0][3])) + ((v[j][1][0] + v[j][1][1]) + (v[j][1][2] + v[j][1][3])); }
            const float mean = wave_sum(s) * (1.0f / DM); float s2 = 0.f;
#pragma unroll
            for (int j = 0; j < 2; ++j)
#pragma unroll
                for (int q = 0; q < 2; ++q) { v[j][q] = v[j][q] - mean; s2 += (v[j][q][0] * v[j][q][0] + v[j][q][1] * v[j][q][1]) + (v[j][q][2] * v[j][q][2] + v[j][q][3] * v[j][q][3]); }
            const float rstd = 1.0f / sqrtf(wave_sum(s2) * (1.0f / DM) + LN_EPS);
            if (F.lane == 0) *(f32x2*)(STATS + (size_t)(r0 + k) * 2) = (f32x2){mean, rstd};
#pragma unroll
            for (int j = 0; j < 2; ++j) { const f32x4 y0 = v[j][0] * rstd * gv[j][0] + bv[j][0], y1 = v[j][1] * rstd * gv[j][1] + bv[j][1]; const size_t o = (size_t)(r0 + k) * DM + 512 * j + 8 * F.lane;
                *(u32x4*)(X1B + o) = pg8::pack8(y0, y1); u32x2 w8; w8.x = pg8::pack4_fp8(y0); w8.y = pg8::pack4_fp8(y1); *(u32x2*)(X1F8 + o) = w8; } }
    }
}
__device__ __forceinline__ void combine_phase(const Frame& F, const bf16_t* Y, const float* STATS, const float* g1, const float* b1, const unsigned char* YS8, const int* INV, const float* g, const float* bb, float* XO, bf16_t* XOB, unsigned char* XO8) {
    for (int row = F.gw; row < NTOK; row += F.NGW) { f32x4 v[4], s[4]; const f32x2 st = *(const f32x2*)(STATS + (size_t)row * 2);
#pragma unroll
        for (int j = 0; j < 4; ++j) { const int c = 256 * j + 4 * F.lane; const u32x2 yw = *(const u32x2*)(Y + (size_t)row * DM + c); const f32x4 yv = {bf_lo(yw.x), bf_hi(yw.x), bf_lo(yw.y), bf_hi(yw.y)};
            v[j] = ((yv - st[0]) * st[1] * *(const f32x4*)(g1 + c) + *(const f32x4*)(b1 + c)) * DN_ALPHA; s[j] = (f32x4){0.f, 0.f, 0.f, 0.f}; }
#pragma unroll
        for (int k = 0; k <= TOPK; ++k) { const size_t sr = (k < TOPK) ? (size_t)INV[row * TOPK + k] : (size_t)NASSIGN + row;
#pragma unroll
            for (int j = 0; j < 4; ++j) { const int w = *(const int*)(YS8 + sr * DM + 256 * j + 4 * F.lane);
                s[j][0] += __builtin_amdgcn_cvt_f32_fp8(w, 0); s[j][1] += __builtin_amdgcn_cvt_f32_fp8(w, 1); s[j][2] += __builtin_amdgcn_cvt_f32_fp8(w, 2); s[j][3] += __builtin_amdgcn_cvt_f32_fp8(w, 3); } }
#pragma unroll
        for (int j = 0; j < 4; ++j) v[j] = v[j] + s[j] * (1.0f / pg8::Y8_SCALE);
        ln_store(F, v, g, bb, XO ? XO + (size_t)row * DM : nullptr, XOB ? XOB + (size_t)row * DM : nullptr, XOB ? XO8 + (size_t)row * DM : nullptr); }
}
__device__ __forceinline__ void route_phase(const Frame& F, const float* SCT, const float* rbias, int* EI, float* TKW, unsigned* cnt) {
    LAS unsigned* hist = (LAS unsigned*)(F.lds);
    for (int blk = F.vcu; blk < NTOK / 128; blk += F.G) {
        if (F.tid < 512) hist[F.tid] = 0u;
        __syncthreads();
        int ek[4]; float wk[4]; unsigned lk[4]; const int hf = F.lane >> 5; const int t = blk * 128 + F.wave * 32 + (F.lane & 31);
        if (F.wave < 4) {
            float gsc[4];
#pragma unroll
            for (int gl = 0; gl < 4; ++gl) { const int e0 = 128 * hf + 32 * gl; float m1 = -INFINITY, m2 = -INFINITY;
#pragma unroll 8
                for (int j = 0; j < 32; ++j) { const float v = SCT[(size_t)(e0 + j) * NTOK + t] + rbias[e0 + j]; m2 = fmaxf(m2, fminf(m1, v)); m1 = fmaxf(m1, v); }
                gsc[gl] = m1 + m2; }
            float og[4];
#pragma unroll
            for (int gl = 0; gl < 4; ++gl) og[gl] = shx(gsc[gl], 32);
            bool keep[4];
#pragma unroll
            for (int gl = 0; gl < 4; ++gl) { int rank = 0;
#pragma unroll
                for (int q = 0; q < 4; ++q) { rank += (q != gl && (gsc[q] > gsc[gl] || (gsc[q] == gsc[gl] && q < gl))) ? 1 : 0;
                    rank += (og[q] > gsc[gl] || (og[q] == gsc[gl] && hf == 1)) ? 1 : 0; }
                keep[gl] = rank < 4; }
            float bv[8], sv[8]; int ev[8];
#pragma unroll
            for (int k = 0; k < 8; ++k) { bv[k] = -INFINITY; sv[k] = 0.f; ev[k] = 0; }
#pragma unroll
            for (int gl = 0; gl < 4; ++gl) { const int e0 = 128 * hf + 32 * gl;
                if (__any(keep[gl])) {
#pragma unroll 4
                    for (int j = 0; j < 32; ++j) { const float s = SCT[(size_t)(e0 + j) * NTOK + t]; const float b = keep[gl] ? s + rbias[e0 + j] : -INFINITY;
                        if (__any(b > bv[7])) {
                            if (b > bv[7]) { bv[7] = b; sv[7] = s; ev[7] = e0 + j; }
#pragma unroll
                            for (int k = 7; k > 0; --k) { const bool sw = bv[k] > bv[k - 1];
                                const float tb = sw ? bv[k - 1] : bv[k], ts = sw ? sv[k - 1] : sv[k]; const int te = sw ? ev[k - 1] : ev[k];
                                bv[k - 1] = sw ? bv[k] : bv[k - 1]; sv[k - 1] = sw ? sv[k] : sv[k - 1]; ev[k - 1] = sw ? ev[k] : ev[k - 1];
                                bv[k] = tb; sv[k] = ts; ev[k] = te; } } } } }
            float wsum = 0.f;
#pragma unroll
            for (int k = 0; k < 8; ++k) { const float ob = shx(bv[7 - k], 32), os = shx(sv[7 - k], 32); const int oe = shx(ev[7 - k], 32);
                const bool mine = (bv[k] > ob) || (bv[k] == ob && ev[k] < oe);
                const float cs = mine ? sv[k] : os; const int ce = mine ? ev[k] : oe; wsum += cs;
                if (k < 4) { ek[k] = ce; wk[k] = cs; } }
#pragma unroll
            for (int k = 0; k < 4; ++k) { wk[k] = wk[k] / wsum * ROUTED_SCALE; lk[k] = __hip_atomic_fetch_add(&hist[ek[k]], 1u, __ATOMIC_RELAXED, __HIP_MEMORY_SCOPE_WORKGROUP); }
        }
        __syncthreads();
        if (F.tid < NEXP) { const unsigned h = hist[F.tid]; hist[256 + F.tid] = h ? atomicAdd(cnt + F.tid, h) : 0u; }
        __syncthreads();
        if (F.wave < 4) {
#pragma unroll
            for (int k = 0; k < 4; ++k) { const int a = t * TOPK + 4 * hf + k; EI[a] = (int)(((hist[256 + ek[k]] + lk[k]) << 8) | (unsigned)ek[k]); TKW[a] = wk[k]; } }
        __syncthreads();
    }
}
__device__ __forceinline__ void moe_tables(const Frame& F, unsigned* cnt) {
    LAS int* ustart = (LAS int*)(F.lds + LDS_TAB); LAS int* eoff = ustart + 264; LAS int* ecnt = eoff + 264;
    if (F.tid < NE1) ecnt[F.tid] = (F.tid < NEXP) ? (int)__hip_atomic_load(cnt + F.tid, __ATOMIC_RELAXED, __HIP_MEMORY_SCOPE_AGENT) : NTOK;
    __syncthreads();
    if (F.tid == 0) { int o = 0, u = 0; for (int e = 0; e < NE1; ++e) { eoff[e] = o; ustart[e] = u; o += ecnt[e]; u += (ecnt[e] + 255) >> 8; } ustart[NE1] = u; eoff[NE1] = o; }
    __syncthreads();
    if (F.tid < NE1) { LAS unsigned short* tmap = (LAS unsigned short*)(ecnt + 264); for (int t = ustart[F.tid]; t < ustart[F.tid + 1]; ++t) tmap[t] = (unsigned short)F.tid; }
    __syncthreads();
}
__device__ __forceinline__ void scatter_phase(const Frame& F, const int* EI, const float* TKW, int* INV, int* RTOK, float* RW) {
    const LAS int* eoff = (const LAS int*)(F.lds + LDS_TAB) + 264;
    for (int a = F.gw * 64 + F.lane; a < NASSIGN; a += F.NGW * 64) { const int ei = EI[a];
        const int pos = eoff[ei & 255] + (int)((unsigned)ei >> 8);
        INV[a] = pos; RTOK[pos] = a >> 3; RW[pos] = TKW[a]; }
    for (int t = F.gw * 64 + F.lane; t < NTOK; t += F.NGW * 64) { RTOK[NASSIGN + t] = t; RW[NASSIGN + t] = 1.0f; }
}

#ifndef MK_PER_PHASE
#define MK_PER_PHASE 0
#endif
constexpr int NPHASE = 1 + 12 * DEPTH;
struct Args { const float* in[24]; float* out; unsigned char* ws; int p_lo, p_hi; };
static_assert(sizeof(Args) == 216, "kernarg layout (karg_* offsets)");

__global__ void __launch_bounds__(NTHREADS, 2) fwd_kernel(Args args) {
    extern __shared__ __attribute__((aligned(16))) unsigned char lds_raw[];
    LAS unsigned char* const lds = (LAS unsigned char*)lds_raw;
#define MKFRAME() Frame F; { F.lds = lds; F.lane = lane_now(); F.wave = opaque_s(wv_); F.tid = F.wave * 64 + F.lane; \
        F.G = opaque_s((int)gridDim.x); const int bx = opaque_s((int)blockIdx.x); F.vcu = (F.G % 8 == 0) ? (bx % 8) * (F.G / 8) + bx / 8 : bx; F.gw = F.vcu * NWAVES + F.wave; F.NGW = F.G * NWAVES; } \
        const int cidx = opaque_s((int)blockIdx.x); (void)cidx;
    volatile LAS unsigned* MISC = (volatile LAS unsigned*)(lds + LDS_MISC);
    const int wv_ = opaque_s(__builtin_amdgcn_readfirstlane((int)threadIdx.x >> 6));
    if (threadIdx.x < 64) MISC[threadIdx.x] = 0u;
    __syncthreads();
    const int lo = args.p_lo, hi = args.p_hi;
    XcdBarrier bar; bar.bar = (unsigned*)(args.ws + WS_CTL) + CW_BAR; bar.x = 0; bar.st = nullptr; bar.wv = wv_;
    if (hi - lo > 1) bar = xcd_barrier_post((unsigned*)(args.ws + WS_CTL) + CW_BAR, MISC + 8, wv_);
#ifdef ONLY_PHASE
#define IN(k) ((((k) == 0) ? 0 : (((k) - 1) % 12) + 1) == ONLY_PHASE && lo <= (k) && (k) < hi)
#else
#define IN(k) (lo <= (k) && (k) < hi)
#endif
#define SEAM(k) do { if (IN(k) && IN((k) + 1)) xcd_barrier(bar); } while (0)
#ifndef PROBE_DUP
#define PROBE_DUP -1
#endif
#ifndef PROBE_REPSEL
#define PROBE_REPSEL -1
#endif
#define REPS(ptype) for (int rep_ = 0; rep_ < ((PROBE_DUP == (ptype)) ? 2 : 1); ++rep_)
#define WSP(T, off) ((T*)(ws + (off)))

    if (IN(0)) REPS(0) { MKFRAME(); const kargp_t kp = karg_base(); unsigned char* ws = karg_ws(kp);
        build_rope(F, ws); convert_x(F, karg_in(kp, 0), WSP(bf16_t, WS_XBF), WSP(unsigned char, WS_XB)); convert_small_weights(F, kp, ws, 0); convert_small_weights(F, kp, ws, 1); __syncthreads(); }
    SEAM(0);

    for (int l = 0; l < DEPTH; ++l) {
        const int pb = 1 + 12 * l;
        if (IN(pb + 0)) REPS(1) { MKFRAME(); const kargp_t kp = karg_base(); unsigned char* ws = karg_ws(kp); const unsigned char* wb = ws + WS_WSMALL + (size_t)l * WSMALL_LAYER;
            { typedef pg8::DenseOrderT<(PROBE_REPSEL == 1) ? 2 : 1> SchedT; SchedT S; S.init(NTOK, 2048, F.G, cidx, 512, (const bf16_t*)(wb + WOF_IN), 512);
              pg8::EpiP1 E{WSP(bf16_t, WS_QKV), WSP(bf16_t, WS_DQKV), WSP(bf16_t, WS_KR), WSP(bf16_t, WS_GATES), WSP(float, WS_SSQ), WSP(float, WS_LOGF), karg_in(kp, 6) + l * 3072, karg_in(kp, 7) + l * 4,
                           WSP(const float, WS_ROPE), WSP(const float, WS_ROPE) + SEQ * 16};
              pg8::gemm_phase<pg8::EpiP1, SchedT, true>(F.lds, F.tid, WSP(const bf16_t, WS_XB), 512, 512, S, E); }
            { typedef pg8::DenseOrderT<(PROBE_REPSEL == 1) ? 2 : 1> SchedT; SchedT S; S.init(NTOK, 3072, F.G, cidx, 512, (const bf16_t*)(wb + WOF_IN + 4 * MiB), 512);
              pg8::EpiGate E{WSP(bf16_t, WS_GATES), karg_in(kp, 6) + l * 3072};
              pg8::gemm_phase<pg8::EpiGate, SchedT, true>(F.lds, F.tid, WSP(const bf16_t, WS_XB), 512, 512, S, E); }
        }
        SEAM(pb + 0);
        if (IN(pb + 1)) REPS(2) { MKFRAME(); const kargp_t kp = karg_base(); unsigned char* ws = karg_ws(kp); const unsigned char* wb = ws + WS_WSMALL + (size_t)l * WSMALL_LAYER;
            cumf_phase(F, ws);
            for (int q = 0; q < 2; ++q) {
                pg8::DenseOrder S; S.init(NTOK, q ? 1024 : 768, F.G, cidx, 512, (const bf16_t*)(wb + (q ? WOF_UKV : WOF_UQ)), 256);
                pg8::EpiQK E{q ? WSP(bf16_t, WS_KVM) : WSP(bf16_t, WS_QM), q ? 1024 : 768, WSP(const float, WS_SSQ) + (q ? 4 : 0), q ? (1.0f / 128.0f) : (1.0f / 256.0f), q ? 1.0f : QS96, q ? -1 : 2,
                             WSP(const float, WS_ROPE), WSP(const float, WS_ROPE) + SEQ * 16};
                pg8::gemm_phase<pg8::EpiQK, pg8::DenseOrder, true>(F.lds, F.tid, WSP(const bf16_t, WS_DQKV) + (q ? 256 : 0), 256, 256, S, E);
            }
        }
        SEAM(pb + 1);
        if (IN(pb + 2)) REPS(3) { MKFRAME(); const kargp_t kp = karg_base(); unsigned char* ws = karg_ws(kp);
            const AttnPtrs AP{WSP(const bf16_t, WS_QKV), WSP(const bf16_t, WS_QM), WSP(const bf16_t, WS_KVM), WSP(const bf16_t, WS_KR), WSP(const float, WS_CUMF), WSP(unsigned char, WS_OCAT)};
            const int cslot = (F.vcu >> 2) % 9; int u = 0; bool conv = false;
            for (int item = F.vcu; item < 1024; item += F.G)
                for (int k = 0; k < 2; ++k, ++u) {
                    if (u == cslot) { __syncthreads(); convert_expert_weights(F, kp, ws, l); __syncthreads(); conv = true; }
                    attn_item(F.lds, F.wave, AP, item, k); }
            if (!conv) { __syncthreads(); convert_expert_weights(F, kp, ws, l); __syncthreads(); } }
        SEAM(pb + 2);
        if (IN(pb + 3)) REPS(4) { MKFRAME(); const kargp_t kp = karg_base(); unsigned char* ws = karg_ws(kp); const unsigned char* wb = ws + WS_WSMALL + (size_t)l * WSMALL_LAYER;
            typedef pg8::DenseOrderT<(PROBE_REPSEL == 4) ? 2 : 1> SchedT; SchedT S; S.init(NTOK, 1024, F.G, cidx, 512, (const bf16_t*)(wb + WOF_PSB), 512);
            pg8::EpiMix E{WSP(bf16_t, WS_MIXG), WSP(const bf16_t, WS_GATES)};
            pg8::gemm_phase<pg8::EpiMix, SchedT, true>(F.lds, F.tid, WSP(const bf16_t, WS_OCAT), 512, 512, S, E);
        }
        SEAM(pb + 3);
        if (IN(pb + 4)) REPS(5) { MKFRAME(); const kargp_t kp = karg_base(); unsigned char* ws = karg_ws(kp); const unsigned char* wb = ws + WS_WSMALL + (size_t)l * WSMALL_LAYER;
            typedef pg8::DenseOrderT<(PROBE_REPSEL == 5) ? 2 : 1> SchedT; SchedT S; S.init(NTOK, 1024, F.G, cidx, 512, (const bf16_t*)(wb + WOF_OUT3), 512);
            pg8::EpiY E{WSP(bf16_t, WS_Y), (l == 0) ? karg_in(kp, 0) : nullptr, WSP(const bf16_t, WS_XBF)};
            pg8::gemm_phase<pg8::EpiY, SchedT, true>(F.lds, F.tid, WSP(const bf16_t, WS_MIXG), 512, 512, S, E);
        }
        SEAM(pb + 4);
        if (IN(pb + 5)) REPS(6) { MKFRAME(); const kargp_t kp = karg_base(); unsigned char* ws = karg_ws(kp);
            ln1_phase(F, WSP(const bf16_t, WS_Y), karg_in(kp, 1) + l * DM, karg_in(kp, 2) + l * DM, WSP(float, WS_STATS), WSP(bf16_t, WS_XBF), WSP(unsigned char, WS_XA)); }
        SEAM(pb + 5);
        if (IN(pb + 6)) REPS(7) { MKFRAME(); const kargp_t kp = karg_base(); unsigned char* ws = karg_ws(kp); const unsigned char* wb = ws + WS_WSMALL + (size_t)l * WSMALL_LAYER;
            pg8::DenseOrder S; S.init(NTOK, 256, F.G, cidx, 1024, (const bf16_t*)(wb + WOF_R), 1024);
            pg8::EpiRouter E{WSP(float, WS_LOGITS)};
            pg8::gemm_phase<pg8::EpiRouter, pg8::DenseOrder, true>(F.lds, F.tid, WSP(const bf16_t, WS_XBF), 1024, 1024, S, E);
        }
        SEAM(pb + 6);
        if (IN(pb + 7)) { MKFRAME(); const kargp_t kp = karg_base(); unsigned char* ws = karg_ws(kp);
            route_phase(F, WSP(const float, WS_LOGITS), karg_in(kp, 17) + l * NEXP, WSP(int, WS_TKI), WSP(float, WS_TKW), WSP(unsigned, WS_CTL) + CW_CNT + l * 1024); __syncthreads(); }
        SEAM(pb + 7);
        if (IN(pb + 8)) { MKFRAME(); const kargp_t kp = karg_base(); unsigned char* ws = karg_ws(kp); unsigned* cnt = WSP(unsigned, WS_CTL) + CW_CNT + l * 1024;
            moe_tables(F, cnt); scatter_phase(F, WSP(const int, WS_TKI), WSP(const float, WS_TKW), WSP(int, WS_INV), WSP(int, WS_RTOK), WSP(float, WS_RW)); __syncthreads(); }
        SEAM(pb + 8);
        if (IN(pb + 9)) REPS(10) { MKFRAME(); const kargp_t kp = karg_base(); unsigned char* ws = karg_ws(kp);
            moe_tables(F, WSP(unsigned, WS_CTL) + CW_CNT + l * 1024);
            const LAS int* ustart = (const LAS int*)(F.lds + LDS_TAB);
            pg8::MoeOrder S{ustart, ustart + 264, ustart + 528, ustart[NE1], 2, F.G, F.vcu, WSP(const int, WS_RTOK), 512, WSP(const bf16_t, WS_WGU), 512, (size_t)512 * 1024};
            pg8::EpiGU E{WSP(bf16_t, WS_H), WSP(const float, WS_RW)};
            pg8::gemm_phase<pg8::EpiGU, pg8::MoeOrder, true>(F.lds, F.tid, WSP(const bf16_t, WS_XA), 512, 512, S, E);
            __syncthreads();
        }
        SEAM(pb + 9);
        if (IN(pb + 10)) REPS(11) { MKFRAME(); const kargp_t kp = karg_base(); unsigned char* ws = karg_ws(kp);
            moe_tables(F, WSP(unsigned, WS_CTL) + CW_CNT + l * 1024);
            const LAS int* ustart = (const LAS int*)(F.lds + LDS_TAB);
            pg8::MoeOrder S{ustart, ustart + 264, ustart + 528, ustart[NE1], 4, F.G, F.vcu, nullptr, 128, WSP(const bf16_t, WS_WD), 128, (size_t)1024 * 256};
            pg8::EpiDown E{WSP(unsigned char, WS_YS)};
            pg8::gemm_phase<pg8::EpiDown, pg8::MoeOrder, true>(F.lds, F.tid, WSP(const bf16_t, WS_H), 128, 128, S, E);
            __syncthreads();
        }
        SEAM(pb + 10);
        if (IN(pb + 11)) REPS(12) { MKFRAME(); const kargp_t kp = karg_base(); unsigned char* ws = karg_ws(kp);
            combine_phase(F, WSP(const bf16_t, WS_Y), WSP(const float, WS_STATS), karg_in(kp, 1) + l * DM, karg_in(kp, 2) + l * DM, WSP(const unsigned char, WS_YS), WSP(const int, WS_INV),
                          karg_in(kp, 3) + l * DM, karg_in(kp, 4) + l * DM, (l == DEPTH - 1) ? karg_out(kp) : nullptr, (l == DEPTH - 1) ? nullptr : WSP(bf16_t, WS_XBF), WSP(unsigned char, WS_XB));
        }
        SEAM(pb + 11);
    }
#undef IN
#undef SEAM
#undef WSP
}

extern "C" void kernel_launch(void* const* d_in, const int* in_sizes, int n_in, void* d_out, int out_size, void* d_ws, size_t ws_size, hipStream_t stream) {
    static int grid = 0;
    if (grid == 0) {
        if (n_in != 24 || in_sizes[0] != NTOK * DM || out_size != NTOK * DM || ws_size < WS_END) {
            fprintf(stderr, "kernel_launch: unexpected shapes (n_in %d, in0 %d, out %d, ws %zu, need %zu); nothing launched\n", n_in, n_in > 0 ? in_sizes[0] : -1, out_size, ws_size, (size_t)WS_END); grid = -1; return; }
        int dev = 0, cus = 0;
        if (hipGetDevice(&dev) != hipSuccess || hipDeviceGetAttribute(&cus, hipDeviceAttributeMultiprocessorCount, dev) != hipSuccess) { grid = -1; return; }
        if (hipFuncSetAttribute((const void*)fwd_kernel, hipFuncAttributeMaxDynamicSharedMemorySize, LDS_BYTES) != hipSuccess) { fprintf(stderr, "kernel_launch: hipFuncSetAttribute failed\n"); grid = -1; return; }
        (void)hipGetLastError();
        grid = cus;
    }
    if (grid < 0) return;
    (void)hipMemsetAsync((char*)d_ws + WS_CTL, 0, CTL_BYTES, stream);
    Args a{};
    for (int i = 0; i < 24; ++i) a.in[i] = (const float*)d_in[i];
    a.out = (float*)d_out; a.ws = (unsigned char*)d_ws;
#if MK_PER_PHASE
    for (int p = 0; p < NPHASE; ++p) { a.p_lo = p; a.p_hi = p + 1; hipLaunchKernelGGL(fwd_kernel, dim3(grid), dim3(NTHREADS), LDS_BYTES, stream, a); }
#else
    a.p_lo = 0; a.p_hi = NPHASE;
    hipLaunchKernelGGL(fwd_kernel, dim3(grid), dim3(NTHREADS), LDS_BYTES, stream, a);
#endif
}
```

```cpp
#include <hip/hip_runtime.h>
#include <cstdio>
#include <cstdint>

#define LAS __attribute__((address_space(3)))
#define GAS __attribute__((address_space(1)))
typedef unsigned short bf16_t;
typedef short bf16x8 __attribute__((ext_vector_type(8)));
typedef short s16x4 __attribute__((ext_vector_type(4)));
typedef float f32x2 __attribute__((ext_vector_type(2)));
typedef float f32x4 __attribute__((ext_vector_type(4)));
typedef float f32x16 __attribute__((ext_vector_type(16)));
typedef unsigned u32x2 __attribute__((ext_vector_type(2)));
typedef unsigned u32x4 __attribute__((ext_vector_type(4)));
typedef int i32x4 __attribute__((ext_vector_type(4)));
typedef int i32x8 __attribute__((ext_vector_type(8)));

constexpr int NTOK = 32768, DM = 1024, SEQ = 2048, NBATCH = 16, DEPTH = 2;
constexpr int IN_WIDTH = 5028, OFF_FGATE = 1536, OFF_DQ = 1540, OFF_DKV = 1796, OFF_KR = 1924, OFF_GATE = 1956;
constexpr int NEXP = 256, TOPK = 8, NE1 = NEXP + 1;
constexpr int NASSIGN = NTOK * TOPK;
constexpr int NROWS = NASSIGN + NTOK;
constexpr float LOG2E = 1.4426950408889634f;
constexpr float QS64 = 0.125f * LOG2E;
constexpr float QS96 = 0.10206207261596575f * LOG2E;
constexpr float DN_ALPHA = 1.4142135623730951f;
constexpr float LN_EPS = 1e-5f, RMS_EPS = 1e-6f, ROUTED_SCALE = 2.5f;
constexpr int NWAVES = 8, NTHREADS = 512;

constexpr size_t MiB = 1u << 20;
constexpr size_t WS_CTL = 0, CTL_BYTES = 1 * MiB;
constexpr size_t WS_ROPE = 1 * MiB;
constexpr size_t WS_WSMALL = 2 * MiB, WSMALL_LAYER = 20 * MiB;
constexpr size_t WOF_IN = 0;
constexpr size_t WOF_UQ = 10 * MiB;
constexpr size_t WOF_UKV = 10 * MiB + 512 * 1024;
constexpr size_t WOF_PSB = 11 * MiB;
constexpr size_t WOF_PFOX = 11 * MiB + 512 * 1024;
constexpr size_t WOF_PMLA = 12 * MiB;
constexpr size_t WOF_OUT3 = 13 * MiB;
constexpr size_t WOF_R = 19 * MiB;
constexpr size_t WS_WGU = 42 * MiB;
constexpr size_t WS_WD = WS_WGU + 257 * MiB;
constexpr size_t WS_XA = 428 * MiB;
constexpr size_t WS_XB = 556 * MiB;
constexpr size_t WS_XBF = 684 * MiB;
constexpr size_t WS_R = 748 * MiB;
constexpr size_t WS_QKV = WS_R;
constexpr size_t WS_DQKV = WS_QKV + 96 * MiB;
constexpr size_t WS_GATES = WS_DQKV + 32 * MiB;
constexpr size_t WS_QM = WS_GATES + 192 * MiB;
constexpr size_t WS_KVM = WS_QM + 48 * MiB;
constexpr size_t WS_OCAT = WS_KVM + 64 * MiB;
constexpr size_t WS_MIXG = WS_OCAT + 64 * MiB;
constexpr size_t WS_Y = WS_MIXG + 192 * MiB;
constexpr size_t WS_KR = WS_Y + 128 * MiB;
constexpr size_t WS_LOGF = WS_KR + 2 * MiB;
constexpr size_t WS_CUMF = WS_LOGF + 512 * 1024;
constexpr size_t WS_SSQ = WS_CUMF + 512 * 1024;
constexpr size_t WS_STATS = WS_SSQ + 1 * MiB;
constexpr size_t WS_ATT_END = WS_STATS + 1 * MiB;
constexpr size_t WS_LOGITS = WS_R;
constexpr size_t WS_TKI = WS_LOGITS + 32 * MiB;
constexpr size_t WS_TKW = WS_TKI + 1 * MiB;
constexpr size_t WS_INV = WS_TKW + 1 * MiB;
constexpr size_t WS_RTOK = WS_INV + 1 * MiB;
constexpr size_t WS_RW = WS_RTOK + 2 * MiB;
constexpr size_t WS_H = WS_RW + 2 * MiB;
constexpr size_t WS_YS = WS_H + 145 * MiB;
constexpr size_t WS_MOE_END = WS_YS + 577 * MiB;
constexpr size_t WS_END = (WS_ATT_END > WS_MOE_END ? WS_ATT_END : WS_MOE_END);
static_assert(WS_END <= 2000 * MiB, "workspace map");

constexpr int CW_BAR = 4096;
constexpr int CW_CNT = 65536;

constexpr int LDS_STAGE = 131072;
constexpr int LDS_TAB = LDS_STAGE;
constexpr int LDS_MISC = LDS_STAGE + 16384;
constexpr int LDS_BYTES = 160 * 1024;

typedef __bf16 bf16x2_t __attribute__((ext_vector_type(2)));
__device__ __forceinline__ unsigned cvt_pk_bf16(float lo, float hi) { const f32x2 v = {lo, hi}; const bf16x2_t b = __builtin_convertvector(v, bf16x2_t); return __builtin_bit_cast(unsigned, b); }
__device__ __forceinline__ float bf_lo(unsigned w) { return __uint_as_float(w << 16); }
__device__ __forceinline__ float bf_hi(unsigned w) { return __uint_as_float(w & 0xffff0000u); }
__device__ __forceinline__ float fast_sigmoid(float x) { return __builtin_amdgcn_rcpf(1.0f + __builtin_amdgcn_exp2f(-x * LOG2E)); }
__device__ __forceinline__ int opaque_v(int x) { asm volatile("" : "+v"(x)); return x; }
__device__ __forceinline__ int opaque_s(int x) { asm volatile("" : "+s"(x)); return x; }
__device__ __forceinline__ int lane_now() { int l; asm volatile("v_mbcnt_lo_u32_b32 %0, -1, 0\n\tv_mbcnt_hi_u32_b32 %0, -1, %0" : "=v"(l)); return l; }
template <typename T> __device__ __forceinline__ T shx(T v, int m) { return __builtin_bit_cast(T, __builtin_amdgcn_ds_bpermute((lane_now() ^ m) << 2, __builtin_bit_cast(int, v))); }
template <typename T> __device__ __forceinline__ T shup(T v, int o) { return __builtin_bit_cast(T, __builtin_amdgcn_ds_bpermute((lane_now() - o) << 2, __builtin_bit_cast(int, v))); }
__device__ __forceinline__ float sum32(float x) { const unsigned u = __float_as_uint(x); const auto r = __builtin_amdgcn_permlane32_swap(u, u, false, false); return __uint_as_float(r[0]) + __uint_as_float(r[1]); }
__device__ __forceinline__ float max32(float x) { const unsigned u = __float_as_uint(x); const auto r = __builtin_amdgcn_permlane32_swap(u, u, false, false); return fmaxf(__uint_as_float(r[0]), __uint_as_float(r[1])); }
__device__ __forceinline__ float wave_sum(float v) {
#pragma unroll
    for (int o = 1; o < 32; o <<= 1) v += shx(v, o);
    return sum32(v);
}

#define XB_TMO      128
#define XB_XCNT(j)  (256  + 64 * (j))
#define XB_XSUB(j)  (1280 + 64 * (j))
#define XB_XGEN(j)  (2304 + 64 * (j))
#define XB_TOP      3328
#define XB_TOPGEN   3392
#define XCD_BAR_WORDS 3456
#define XB_SPIN_CAP (1u << 18)
__device__ __forceinline__ unsigned xb_ld(unsigned* p)              { return __hip_atomic_load(p, __ATOMIC_RELAXED, __HIP_MEMORY_SCOPE_AGENT); }
__device__ __forceinline__ unsigned xb_add(unsigned* p, unsigned v) { return __hip_atomic_fetch_add(p, v, __ATOMIC_RELAXED, __HIP_MEMORY_SCOPE_AGENT); }
__device__ __forceinline__ unsigned xb_xcc_id() { return (unsigned)__builtin_amdgcn_s_getreg((3 << 11) | 20) & 0xFu; }
#define XB_SPIN(cond, bar) do { unsigned _sp = 0; while (cond) { __builtin_amdgcn_s_sleep(1); \
    if ((++_sp & 255u) == 0u) { if (xb_ld(&(bar)[XB_TMO])) break; if (_sp > XB_SPIN_CAP) { atomicAdd(&(bar)[XB_TMO], 1u); break; } } } } while (0)
struct XcdBarrier { unsigned* bar; unsigned x; volatile LAS unsigned* st; int wv; };
__device__ __forceinline__ XcdBarrier xcd_barrier_post(unsigned* bar, volatile LAS unsigned* st, int wv) {
    XcdBarrier b; b.bar = bar; b.x = xb_xcc_id(); b.st = st; b.wv = wv;
    if (threadIdx.x == 0) (void)xb_add(&bar[XB_XCNT(b.x)], 1u);
    return b;
}
__device__ __forceinline__ void xcd_barrier_complete(unsigned* bar, unsigned x, unsigned& nloc, unsigned& nx) {
    const unsigned G = gridDim.x * gridDim.y * gridDim.z;
    unsigned sum, cnt, mine, sp = 0u;
    for (;;) {
        sum = 0u; cnt = 0u; mine = 0u;
#pragma unroll
        for (unsigned j = 0; j < 16; ++j) { const unsigned c = xb_ld(&bar[XB_XCNT(j)]); sum += c; cnt += (c > 0u) ? 1u : 0u; mine = (j == x) ? c : mine; }
        if (sum == G) break;
        __builtin_amdgcn_s_sleep(1);
        if ((++sp & 255u) == 0u) { if (xb_ld(&bar[XB_TMO])) break; if (sp > XB_SPIN_CAP) { atomicAdd(&bar[XB_TMO], 1u); break; } }
    }
    nloc = mine > 0u ? mine : 1u; nx = cnt > 0u ? cnt : 1u;
}
__device__ __forceinline__ void xcd_barrier(const XcdBarrier& b) {
    asm volatile("s_waitcnt vmcnt(0)" ::: "memory");
    __syncthreads();
    if (b.wv == 0 && lane_now() == 0) {
        unsigned* bar = b.bar;
        __builtin_amdgcn_s_waitcnt(0);
        unsigned nloc = b.st[0], nx = b.st[1];
        if (nloc == 0u) { xcd_barrier_complete(bar, b.x, nloc, nx); b.st[0] = nloc; b.st[1] = nx; }
        const unsigned old = xb_add(&bar[XB_XSUB(b.x)], 1u);
        const unsigned gen = old / nloc;
        if (old + 1u == (gen + 1u) * nloc) {
            __builtin_amdgcn_fence(__ATOMIC_RELEASE, "agent");
            asm volatile("s_waitcnt vmcnt(0)" ::: "memory");
            const unsigned og = xb_add(&bar[XB_TOP], 1u);
            const unsigned tg = og / nx;
            if (og + 1u == (tg + 1u) * nx) xb_add(&bar[XB_TOPGEN], 1u);
            else XB_SPIN(xb_ld(&bar[XB_TOPGEN]) == tg, bar);
            __builtin_amdgcn_fence(__ATOMIC_ACQUIRE, "agent");
            xb_add(&bar[XB_XGEN(b.x)], 1u);
            asm volatile("s_waitcnt vmcnt(0)" ::: "memory");
        } else {
            XB_SPIN(xb_ld(&bar[XB_XGEN(b.x)]) == gen, bar);
            __builtin_amdgcn_fence(__ATOMIC_ACQUIRE, "agent");
            asm volatile("s_waitcnt vmcnt(0)" ::: "memory");
        }
    }
    __syncthreads();
}

namespace pg8 {
constexpr int BM = 256, BK = 64, HALF = 128, HTB = HALF * BK * 2, STAGE_BYTES = 8 * HTB;
__host__ __device__ __forceinline__ int lds_byte(int r, int c) { const int st = (r >> 4) * 2 + (c >> 5), rr = r & 15, cc = c & 31, ob = rr * 64 + cc * 2; return st * 1024 + (ob ^ (((ob >> 9) & 1) << 5)); }
__host__ __device__ __forceinline__ void stage_rc(int b, int& R, int& C) { const int st = b / 1024, sb = b % 1024, swz = sb ^ (((sb >> 9) & 1) << 5); R = (st >> 1) * 16 + swz / 64; C = (st & 1) * 32 + (swz % 64) / 2; }
__host__ __device__ __forceinline__ int perm32(int rho) { const int n = rho >> 4, i = rho & 15; return 8 * (i >> 2) + 4 * n + (i & 3); }

struct Unit { int row0, pn, e, lim; };

template <int REP> struct DenseOrderT {
    int nM, nN, nwg, G, c; int lda; const bf16_t* Bt; int ldb;
    __device__ void init(int M, int N, int G_, int c_, int lda_, const bf16_t* Bt_, int ldb_) { nM = M / BM; nN = N / BM; nwg = nM * nN; G = G_; c = c_; lda = lda_; Bt = Bt_; ldb = ldb_; }
    __device__ __forceinline__ bool next(int i, Unit& u) const {
        long L = (long)i * G + c; if (L >= (long)nwg * REP) return false; if (REP > 1) L %= nwg;
        int wgid = (int)L; { const int q = nwg / 8, r = nwg % 8, xcd = wgid % 8, off = wgid / 8; wgid = (xcd < r ? xcd * (q + 1) : r * (q + 1) + (xcd - r) * q) + off; }
        const int nig = 8 * nN, gid = wgid / nig, fm = gid * 8, gsz = (nM - fm) < 8 ? (nM - fm) : 8;
        u.row0 = (fm + ((wgid % nig) % gsz)) * BM; u.pn = (wgid % nig) / gsz; u.e = 0; u.lim = BM; return true;
    }
    static constexpr bool UNIFORM_A = true;
    __device__ __forceinline__ unsigned a_off(const Unit&, int rl, int C) const { return (unsigned)(rl * lda + C) * 2u; }
    __device__ __forceinline__ size_t a_base(const Unit& u) const { return (size_t)u.row0 * lda * 2; }
    __device__ __forceinline__ const char* b_base(const Unit& u) const { return (const char*)Bt + (size_t)u.pn * BM * ldb * 2; }
};
typedef DenseOrderT<1> DenseOrder;
struct MoeOrder {
    const LAS int* ustart; const LAS int* eoff; const LAS int* ecnt; int ntile, NP, G, c;
    const int* rowtok; int lda; const bf16_t* Bt; int ldb; size_t bstride;
    __device__ __forceinline__ bool next(int i, Unit& u) const {
        const long L = (long)i * G + c; if (L >= (long)ntile * NP) return false;
        const int tile = (int)(L / NP); u.pn = (int)(L % NP);
        const int lo = (int)((const LAS unsigned short*)(ecnt + 264))[tile];
        const int j = tile - ustart[lo];
        u.e = lo; u.row0 = eoff[lo] + BM * j; const int rem = ecnt[lo] - BM * j; u.lim = rem < BM ? rem : BM; return true;
    }
    static constexpr bool UNIFORM_A = false;
    __device__ __forceinline__ size_t a_base(const Unit&) const { return 0; }
    __device__ __forceinline__ unsigned a_off(const Unit& u, int rl, int C) const {
        const int r = u.row0 + (rl < u.lim ? rl : u.lim - 1);
        const int ar = rowtok ? rowtok[r] : r;
        return (unsigned)(ar * lda + C) * 2u;
    }
    __device__ __forceinline__ const char* b_base(const Unit& u) const { return (const char*)Bt + (size_t)u.e * bstride + (size_t)u.pn * BM * ldb * 2; }
};

template <int N> __device__ __forceinline__ void wait_vm() { asm volatile("s_waitcnt vmcnt(%0)" :: "n"(N) : "memory"); }
template <class Epi, class Sched, bool ALIGN_EPI>
__device__ __forceinline__ void gemm_phase(LAS unsigned char* lds, int tid_, const bf16_t* Abase_, int K, int ldb, const Sched& S, const Epi& E) {
    const int tid = opaque_v(tid_), wid = __builtin_amdgcn_readfirstlane(tid >> 6), lane = tid & 63, wr = wid >> 2, wc = wid & 3, fr = lane & 15, fq = lane >> 4;
    const int nt = K / BK;
    constexpr int NST = Epi::NST; static_assert(NST == 0 || Epi::F8, "counted store waits need the peeled first trip");
    const char* Abase = (const char*)Abase_;
    int RA[2], CA[2]; unsigned voffB[2];
#pragma unroll
    for (int i = 0; i < 2; ++i) { int R, C; stage_rc(tid * 16 + i * 8192, R, C); const int Rb = Epi::PERM ? ((R & ~31) + perm32(R & 31)) : R;
        RA[i] = R; CA[i] = C; voffB[i] = (unsigned)(Rb * ldb + C) * 2u; }
    const size_t kstep = (size_t)(BK * 2);
    const size_t hstepB = (size_t)HALF * ldb * 2;
    const unsigned ldsw = (unsigned)wid * 1024u;
    const int aoff = Epi::F8 ? lds_byte(wr * 64 + fr, fq * 16) : lds_byte(wr * 64 + fr, fq * 8), boff = Epi::F8 ? lds_byte(wc * 32 + fr, fq * 16) : lds_byte(wc * 32 + fr, fq * 8);
#define PG8_SA(b, h) (((b) * 2 + (h)) * HTB)
#define PG8_SB(b, h) ((4 + (b) * 2 + (h)) * HTB)
#define PG8_STAGE2(bufoff, gbase, o0, o1) do { \
        __builtin_amdgcn_global_load_lds((const unsigned*)((const char*)(gbase) + (unsigned)opaque_v((int)(o0))), (LAS unsigned*)(lds + (bufoff) + ldsw), 16, 0, 0); \
        __builtin_amdgcn_global_load_lds((const unsigned*)((const char*)(gbase) + (unsigned)opaque_v((int)(o1))), (LAS unsigned*)(lds + (bufoff) + ldsw + 8192), 16, 0, 0); } while (0)
#define PG8_STAGEB(bufoff, gbase) PG8_STAGE2(bufoff, gbase, voffB[0], voffB[1])
#define PG8_LD32(p) __builtin_shufflevector(*(const LAS i32x4*)(p), *(const LAS i32x4*)((p) + 16), 0, 1, 2, 3, 4, 5, 6, 7)
#define PG8_LDA(dst, b, h) do { if constexpr (Epi::F8) { _Pragma("unroll") for (int m = 0; m < 4; ++m) dst##8[m] = PG8_LD32(lds + PG8_SA(b, h) + aoff + m * 2048); } \
        else { _Pragma("unroll") for (int m = 0; m < 4; ++m) _Pragma("unroll") for (int k = 0; k < 2; ++k) dst[m][k] = *(const LAS bf16x8*)(lds + PG8_SA(b, h) + aoff + m * 2048 + k * 1024); } } while (0)
#define PG8_LDB(dst, b, h) do { if constexpr (Epi::F8) { _Pragma("unroll") for (int n = 0; n < 2; ++n) dst##8[n] = PG8_LD32(lds + PG8_SB(b, h) + boff + n * 2048); } \
        else { _Pragma("unroll") for (int n = 0; n < 2; ++n) _Pragma("unroll") for (int k = 0; k < 2; ++k) dst[n][k] = *(const LAS bf16x8*)(lds + PG8_SB(b, h) + boff + n * 2048 + k * 1024); } } while (0)
#define PG8_MMA(ai, bj, At, Bt) PG8_MMAZ(ai, bj, At, Bt, false)
#define PG8_MMAZ(ai, bj, At, Bt, Z) do { __builtin_amdgcn_s_setprio(1); \
        if constexpr (Epi::F8) { if constexpr (Z) { _Pragma("unroll") for (int m = 0; m < 4; ++m) _Pragma("unroll") for (int n = 0; n < 2; ++n) \
            asm volatile("v_mfma_scale_f32_16x16x128_f8f6f4 %0, %1, %2, 0, %3, %3 op_sel_hi:[0,0,0]" : "=&v"(acc[ai][bj][m][n]) : "v"(Bt##8[n]), "v"(At##8[m]), "v"(f8one)); } \
          else { _Pragma("unroll") for (int m = 0; m < 4; ++m) _Pragma("unroll") for (int n = 0; n < 2; ++n) \
            asm volatile("v_mfma_scale_f32_16x16x128_f8f6f4 %0, %1, %2, %0, %3, %3 op_sel_hi:[0,0,0]" : "+v"(acc[ai][bj][m][n]) : "v"(Bt##8[n]), "v"(At##8[m]), "v"(f8one)); } } \
        else { _Pragma("unroll") for (int m = 0; m < 4; ++m) _Pragma("unroll") for (int n = 0; n < 2; ++n) _Pragma("unroll") for (int k = 0; k < 2; ++k) \
            acc[ai][bj][m][n] = __builtin_amdgcn_mfma_f32_16x16x32_bf16(Bt[n][k], At[m][k], acc[ai][bj][m][n], 0, 0, 0); } \
        __builtin_amdgcn_s_setprio(0); } while (0)
#define PG8_WAIT_V(n) asm volatile("s_waitcnt vmcnt(" #n ")" ::: "memory")
#define PG8_WAIT_L(n) asm volatile("s_waitcnt lgkmcnt(" #n ")" ::: "memory")
#define PG8_BAR __builtin_amdgcn_s_barrier()
#define PG8_SCHED __builtin_amdgcn_sched_barrier(0)
    Unit cur, nxt; int ui = 0;
    if (!S.next(0, cur)) return;
    f32x4 acc[2][2][4][2];
    if constexpr (!Epi::F8) {
#pragma unroll
    for (int a = 0; a < 2; ++a)
#pragma unroll
        for (int b = 0; b < 2; ++b)
#pragma unroll
            for (int m = 0; m < 4; ++m)
#pragma unroll
                for (int n = 0; n < 2; ++n) acc[a][b][m][n] = (f32x4){0.f, 0.f, 0.f, 0.f};
    }
    bf16x8 At[4][2], B0[2][2], B1[2][2];
    int f8one = 0x7F7F7F7F; asm volatile("" : "+v"(f8one));
    i32x8 At8[4], B08[2], B18[2];
    unsigned c00 = S.a_off(cur, RA[0], CA[0]), c01 = S.a_off(cur, RA[1], CA[1]), c10 = S.a_off(cur, RA[0] + HALF, CA[0]), c11 = S.a_off(cur, RA[1] + HALF, CA[1]);
    unsigned n00 = c00, n01 = c01, n10 = c10, n11 = c11;
    const char* cA = Abase + S.a_base(cur);
    const char* cB = S.b_base(cur);
    PG8_STAGEB(PG8_SB(0, 0), cB); PG8_STAGEB(PG8_SB(0, 1), cB + hstepB); PG8_STAGE2(PG8_SA(0, 0), cA, c00, c01); PG8_STAGE2(PG8_SA(0, 1), cA, c10, c11);
    if (wr == 1) PG8_BAR;
    PG8_WAIT_V(2); PG8_BAR;
    PG8_STAGEB(PG8_SB(1, 0), cB + kstep); PG8_STAGE2(PG8_SA(1, 0), cA + kstep, c00, c01); PG8_STAGEB(PG8_SB(1, 1), cB + hstepB + kstep);
    if constexpr (NST > 0) PG8_WAIT_V(0); else PG8_WAIT_V(6);
    PG8_BAR;
    for (;;) {
        const bool has_next = S.next(ui + 1, nxt);
        const char* nB; const char* nA;
        if (has_next) { if constexpr (!Sched::UNIFORM_A) { int R0, C0, R1, C1; { const int t2 = opaque_v(tid); stage_rc(t2 * 16, R0, C0); stage_rc(t2 * 16 + 8192, R1, C1); }
                n00 = S.a_off(nxt, R0, C0); n01 = S.a_off(nxt, R1, C1); n10 = S.a_off(nxt, R0 + HALF, C0); n11 = S.a_off(nxt, R1 + HALF, C1); }
            nB = S.b_base(nxt); nA = Abase + S.a_base(nxt); }
        else { if constexpr (!Sched::UNIFORM_A) { n00 = c00; n01 = c01; n10 = c10; n11 = c11; } nB = cB; nA = cA; }
#define PG8_TRIP(ZC) do { \
            const bool last = (t == nt - 2); \
            if constexpr (Epi::MIDK) { if (t == 2 || t == 4) E.midk(acc, cur, t, wr, wc, fr, fq); } \
            const char* a1 = cA + (size_t)(t + 1) * kstep; \
            const char* a2 = last ? nA : cA + (size_t)(t + 2) * kstep; const char* b2 = last ? nB : cB + (size_t)(t + 2) * kstep; \
            const char* a3 = a2 + kstep; const char* b3 = b2 + kstep; \
            unsigned x00 = c00, x01 = c01, x10 = c10, x11 = c11; \
            if constexpr (!Sched::UNIFORM_A) { x00 = last ? n00 : c00; x01 = last ? n01 : c01; x10 = last ? n10 : c10; x11 = last ? n11 : c11; } \
            PG8_LDB(B0, 0, 0); PG8_LDB(B1, 0, 1); PG8_SCHED; PG8_LDA(At, 0, 0); PG8_STAGE2(PG8_SA(1, 1), a1, c10, c11); \
            wait_vm<(ZC) ? 8 + NST : 8>(); PG8_WAIT_L(0); PG8_BAR; PG8_MMAZ(0, 0, At, B0, ZC); PG8_MMAZ(0, 1, At, B1, ZC); PG8_BAR; PG8_SCHED; \
            PG8_LDA(At, 0, 1); PG8_STAGEB(PG8_SB(0, 0), b2); PG8_STAGEB(PG8_SB(0, 1), b2 + hstepB); PG8_STAGE2(PG8_SA(0, 0), a2, x00, x01); \
            wait_vm<(ZC) ? 8 + NST : 8>(); PG8_WAIT_L(0); PG8_BAR; PG8_MMAZ(1, 0, At, B0, ZC); PG8_MMAZ(1, 1, At, B1, ZC); PG8_BAR; PG8_SCHED; \
            PG8_LDB(B0, 1, 0); PG8_LDB(B1, 1, 1); PG8_SCHED; PG8_LDA(At, 1, 0); PG8_STAGE2(PG8_SA(0, 1), a2, x10, x11); \
            wait_vm<((ZC) && NST) ? 10 + NST : 8>(); PG8_WAIT_L(0); PG8_BAR; PG8_MMA(0, 0, At, B0); PG8_MMA(0, 1, At, B1); PG8_BAR; PG8_SCHED; \
            PG8_LDA(At, 1, 1); PG8_STAGEB(PG8_SB(1, 0), b3); PG8_STAGEB(PG8_SB(1, 1), b3 + hstepB); PG8_STAGE2(PG8_SA(1, 0), a3, x00, x01); \
            PG8_WAIT_V(8); PG8_WAIT_L(0); PG8_BAR; PG8_MMA(1, 0, At, B0); PG8_MMA(1, 1, At, B1); PG8_BAR; PG8_SCHED; } while (0)
        if constexpr (Epi::F8) { const int t = 0; PG8_TRIP(true); }
#pragma unroll 1
        for (int t = Epi::F8 ? 2 : 0; t < nt; t += 2) PG8_TRIP(false);
#undef PG8_TRIP
        if constexpr (Epi::F8) asm volatile("s_nop 15\n\ts_nop 15" ::: "memory");
        if constexpr (ALIGN_EPI) { if (wr == 0) PG8_BAR; }
        E(acc, cur, wr, wc, fr, fq);
        if (!has_next) break;
        if constexpr (!Epi::F8)
#pragma unroll
        for (int a = 0; a < 2; ++a)
#pragma unroll
            for (int b = 0; b < 2; ++b)
#pragma unroll
                for (int m = 0; m < 4; ++m)
#pragma unroll
                    for (int n = 0; n < 2; ++n) acc[a][b][m][n] = (f32x4){0.f, 0.f, 0.f, 0.f};
        cur = nxt; cB = nB; cA = nA; if constexpr (!Sched::UNIFORM_A) { c00 = n00; c01 = n01; c10 = n10; c11 = n11; } ++ui;
        if constexpr (ALIGN_EPI) { if (wr == 1) PG8_BAR; }
    }
    PG8_WAIT_V(0);
    if constexpr (!ALIGN_EPI) { if (wr == 0) PG8_BAR; }
    PG8_BAR;
#undef PG8_SA
#undef PG8_SB
#undef PG8_STAGE2
#undef PG8_STAGEB
#undef PG8_LDA
#undef PG8_LDB
#undef PG8_MMA
#undef PG8_LD32
#undef PG8_WAIT_V
#undef PG8_WAIT_L
#undef PG8_BAR
#undef PG8_SCHED
}

typedef f32x4 Acc[2][2][4][2];
__device__ __forceinline__ u32x4 pack8(const f32x4 a, const f32x4 b) { u32x4 w; w.x = cvt_pk_bf16(a[0], a[1]); w.y = cvt_pk_bf16(a[2], a[3]); w.z = cvt_pk_bf16(b[0], b[1]); w.w = cvt_pk_bf16(b[2], b[3]); return w; }

__device__ __forceinline__ void rope8(f32x4& v0, f32x4& v1, int pos, int fq, const float* rc, const float* rs) {
    const int i0 = 8 * (fq & 1);
    const f32x4 c0 = *(const f32x4*)(rc + pos * 16 + i0), c1 = *(const f32x4*)(rc + pos * 16 + i0 + 4);
    f32x4 s0 = *(const f32x4*)(rs + pos * 16 + i0), s1 = *(const f32x4*)(rs + pos * 16 + i0 + 4);
    if (fq < 2) { s0 = -s0; s1 = -s1; }
    f32x4 p0, p1;
#pragma unroll
    for (int e = 0; e < 4; ++e) { p0[e] = shx(v0[e], 32); p1[e] = shx(v1[e], 32); }
    v0 = v0 * c0 + p0 * s0; v1 = v1 * c1 + p1 * s1;
}

constexpr float W8_SCALE = 32.0f;
constexpr float H8_SCALE = 8.0f;
constexpr float MIX8_SCALE = 8.0f;
__device__ __forceinline__ unsigned pack4_fp8(const f32x4 a) {
    int w = __builtin_amdgcn_cvt_pk_fp8_f32(a[0], a[1], 0, false); w = __builtin_amdgcn_cvt_pk_fp8_f32(a[2], a[3], w, true); return (unsigned)w; }
typedef short s16x2 __attribute__((ext_vector_type(2)));
__device__ __forceinline__ unsigned pack4_fp8_div(const f32x4 a, float scale) {
    s16x2 w = {0, 0}; w = __builtin_amdgcn_cvt_scalef32_pk_fp8_f32(w, a[0], a[1], scale, false); w = __builtin_amdgcn_cvt_scalef32_pk_fp8_f32(w, a[2], a[3], scale, true); return __builtin_bit_cast(unsigned, w); }
struct EpiP1 {
    static constexpr bool PERM = true, MIDK = false, F8 = true; static constexpr int NST = 0;
    bf16_t* QKV; bf16_t* DQKV; bf16_t* KR; bf16_t* GATES; float* SSQ; float* LOGF; const float* bgate; const float* bforget; const float* rc; const float* rs;
    __device__ __forceinline__ void operator()(const Acc& acc_, const Unit& u, int wr, int wc, int fr, int fq) const {
        Acc acc;
#pragma unroll
        for (int a = 0; a < 2; ++a)
#pragma unroll
            for (int b = 0; b < 2; ++b)
#pragma unroll
                for (int m = 0; m < 4; ++m)
#pragma unroll
                    for (int n = 0; n < 2; ++n) acc[a][b][m][n] = acc_[a][b][m][n] * (1.0f / W8_SCALE);
        const int pn = u.pn, row0 = u.row0 + wr * 64 + fr, lc = wc * 32 + 8 * fq;
        if (pn < 6) {
            const float sc = (pn == 0 || pn == 3) ? QS64 : 1.0f;
#pragma unroll
            for (int ai = 0; ai < 2; ++ai)
#pragma unroll
                for (int m = 0; m < 4; ++m) { bf16_t* rowp = QKV + (size_t)(row0 + ai * HALF + m * 16) * 1536 + pn * 256 + lc;
#pragma unroll
                    for (int bj = 0; bj < 2; ++bj) *(u32x4*)(rowp + bj * HALF) = pack8(acc[ai][bj][m][0] * sc, acc[ai][bj][m][1] * sc); }
        } else if (pn == 6) {
#pragma unroll
            for (int ai = 0; ai < 2; ++ai)
#pragma unroll
                for (int m = 0; m < 4; ++m) { const int row = row0 + ai * HALF + m * 16; float ss = 0.f;
#pragma unroll
                    for (int bj = 0; bj < 2; ++bj)
#pragma unroll
                        for (int n = 0; n < 2; ++n) { const f32x4 x = acc[ai][bj][m][n]; ss += (x[0] * x[0] + x[1] * x[1]) + (x[2] * x[2] + x[3] * x[3]); }
                    ss += shx(ss, 16); ss = sum32(ss);
                    if (fq == 0) SSQ[(size_t)row * 8 + wc] = ss;
#pragma unroll
                    for (int bj = 0; bj < 2; ++bj) *(u32x4*)(DQKV + (size_t)row * 512 + bj * HALF + lc) = pack8(acc[ai][bj][m][0], acc[ai][bj][m][1]); }
        } else if (pn == 7) {
#pragma unroll
            for (int ai = 0; ai < 2; ++ai)
#pragma unroll
                for (int m = 0; m < 4; ++m) { const int row = row0 + ai * HALF + m * 16; float ss = 0.f;
#pragma unroll
                    for (int n = 0; n < 2; ++n) { const f32x4 x = acc[ai][0][m][n]; ss += (x[0] * x[0] + x[1] * x[1]) + (x[2] * x[2] + x[3] * x[3]); }
                    ss += shx(ss, 16); ss = sum32(ss);
                    if (fq == 0) SSQ[(size_t)row * 8 + 4 + wc] = ss;
                    *(u32x4*)(DQKV + (size_t)row * 512 + 256 + lc) = pack8(acc[ai][0][m][0], acc[ai][0][m][1]);
                    f32x4 v0 = acc[ai][1][m][0], v1 = acc[ai][1][m][1];
                    if (wc == 0) { rope8(v0, v1, row & (SEQ - 1), fq, rc, rs); *(u32x4*)(KR + (size_t)row * 32 + 8 * fq) = pack8(v0, v1); }
                    *(u32x4*)(DQKV + (size_t)row * 512 + 384 + lc) = pack8(v0, v1);
                    if (wc == 1 && fq == 0) { f32x4 o;
#pragma unroll
                        for (int e = 0; e < 4; ++e) { const float x = acc[ai][1][m][0][e] + bforget[e]; o[e] = LOG2E * (fminf(x, 0.f) - log1pf(expf(-fabsf(x)))); }
                        *(f32x4*)(LOGF + (size_t)row * 4) = o; } }
        } else {
            const int gc0 = (pn - 8) * 256 + lc;
            f32x4 bv[2][2];
#pragma unroll
            for (int bj = 0; bj < 2; ++bj)
#pragma unroll
                for (int n = 0; n < 2; ++n) bv[bj][n] = *(const f32x4*)(bgate + gc0 + bj * HALF + 4 * n);
#pragma unroll
            for (int ai = 0; ai < 2; ++ai)
#pragma unroll
                for (int m = 0; m < 4; ++m) { bf16_t* rowp = GATES + (size_t)(row0 + ai * HALF + m * 16) * 3072 + gc0;
#pragma unroll
                    for (int bj = 0; bj < 2; ++bj) { f32x4 a = acc[ai][bj][m][0] + bv[bj][0], b = acc[ai][bj][m][1] + bv[bj][1];
#pragma unroll
                        for (int e = 0; e < 4; ++e) { a[e] = fast_sigmoid(a[e]); b[e] = fast_sigmoid(b[e]); }
                        *(u32x4*)(rowp + bj * HALF) = pack8(a, b); } }
        }
    }
};

struct EpiGate {
    static constexpr bool PERM = true, MIDK = false, F8 = true; static constexpr int STAGGER = 0; static constexpr int NST = 0;
    bf16_t* GATES; const float* bgate;
    __device__ __forceinline__ void operator()(const Acc& acc, const Unit& u, int wr, int wc, int fr, int fq) const {
        const int row0 = u.row0 + wr * 64 + fr, gc0 = u.pn * 256 + wc * 32 + 8 * fq;
        f32x4 bv[2][2];
#pragma unroll
        for (int bj = 0; bj < 2; ++bj)
#pragma unroll
            for (int n = 0; n < 2; ++n) bv[bj][n] = *(const f32x4*)(bgate + gc0 + bj * HALF + 4 * n);
#pragma unroll
        for (int ai = 0; ai < 2; ++ai)
#pragma unroll
            for (int m = 0; m < 4; ++m) { bf16_t* rowp = GATES + (size_t)(row0 + ai * HALF + m * 16) * 3072 + gc0;
#pragma unroll
                for (int bj = 0; bj < 2; ++bj) { f32x4 a = acc[ai][bj][m][0] * (1.0f / W8_SCALE) + bv[bj][0], b = acc[ai][bj][m][1] * (1.0f / W8_SCALE) + bv[bj][1];
#pragma unroll
                    for (int e = 0; e < 4; ++e) { a[e] = fast_sigmoid(a[e]); b[e] = fast_sigmoid(b[e]); }
                    *(u32x4*)(rowp + bj * HALF) = pack8(a, b); } }
    }
};
struct EpiQK {
    static constexpr bool PERM = true, MIDK = false, F8 = false; static constexpr int NST = 0;
    bf16_t* O; int ldo; const float* SSQ; float invn, scale; int rope_pn; const float* rc; const float* rs;
    __device__ __forceinline__ void operator()(const Acc& acc, const Unit& u, int wr, int wc, int fr, int fq) const {
        const int pn = u.pn, row0 = u.row0 + wr * 64 + fr, lc = wc * 32 + 8 * fq;
        f32x4 sq[2][4];
#pragma unroll
        for (int ai = 0; ai < 2; ++ai)
#pragma unroll
            for (int m = 0; m < 4; ++m) sq[ai][m] = *(const f32x4*)(SSQ + (size_t)(row0 + ai * HALF + m * 16) * 8);
#pragma unroll
        for (int ai = 0; ai < 2; ++ai)
#pragma unroll
            for (int m = 0; m < 4; ++m) { const int row = row0 + ai * HALF + m * 16; const f32x4 s4 = sq[ai][m];
                const float rsd = scale * __builtin_amdgcn_rsqf(((s4[0] + s4[1]) + (s4[2] + s4[3])) * invn + RMS_EPS);
#pragma unroll
                for (int bj = 0; bj < 2; ++bj) { f32x4 v0 = acc[ai][bj][m][0] * rsd, v1 = acc[ai][bj][m][1] * rsd;
                    if (pn == rope_pn) rope8(v0, v1, row & (SEQ - 1), fq, rc, rs);
                    *(u32x4*)(O + (size_t)row * ldo + pn * 256 + bj * HALF + lc) = pack8(v0, v1); } }
    }
};
struct EpiMix {
    static constexpr bool PERM = true, MIDK = true, F8 = true; static constexpr int NST = 0;
    bf16_t* MIXED; const bf16_t* GATES;
    __device__ __forceinline__ void midk(Acc& acc, const Unit& u, int t, int wr, int wc, int fr_, int fq_) const {
        const int fr = opaque_v(fr_), fq = opaque_v(fq_);
        const int row0 = u.row0 + wr * 64 + fr, col0 = ((t == 2) ? 0 : 1024) + u.pn * 256 + wc * 32 + 8 * fq;
#pragma unroll
        for (int ai = 0; ai < 2; ++ai)
#pragma unroll
            for (int m = 0; m < 4; ++m) { const size_t ro = (size_t)(row0 + ai * HALF + m * 16) * 3072 + col0;
#pragma unroll
                for (int bj = 0; bj < 2; ++bj) { const u32x4 ga = *(const u32x4*)(GATES + ro + bj * HALF), gb = *(const u32x4*)(GATES + ro + 1024 + bj * HALF);
                    f32x4 n0 = {bf_lo(ga.x), bf_hi(ga.x), bf_lo(ga.y), bf_hi(ga.y)}, n1 = {bf_lo(ga.z), bf_hi(ga.z), bf_lo(ga.w), bf_hi(ga.w)};
                    const f32x4 d0 = {bf_lo(gb.x), bf_hi(gb.x), bf_lo(gb.y), bf_hi(gb.y)}, d1 = {bf_lo(gb.z), bf_hi(gb.z), bf_lo(gb.w), bf_hi(gb.w)};
#pragma unroll
                    for (int e = 0; e < 4; ++e) { n0[e] *= __builtin_amdgcn_rcpf(fmaxf(d0[e], 1e-12f)); n1[e] *= __builtin_amdgcn_rcpf(fmaxf(d1[e], 1e-12f)); }
                    acc[ai][bj][m][0] = acc[ai][bj][m][0] * n0; acc[ai][bj][m][1] = acc[ai][bj][m][1] * n1; }
                if (m == 3) asm volatile("" ::: "memory"); }
    }
    __device__ __forceinline__ void operator()(const Acc& acc, const Unit& u, int wr, int wc, int fr, int fq) const {
        const int row0 = u.row0 + wr * 64 + fr, col0 = u.pn * 256 + wc * 32 + 8 * fq;
        u32x4 gv[2][4][2];
#pragma unroll
        for (int ai = 0; ai < 2; ++ai)
#pragma unroll
            for (int m = 0; m < 4; ++m)
#pragma unroll
                for (int bj = 0; bj < 2; ++bj) gv[ai][m][bj] = *(const u32x4*)(GATES + (size_t)(row0 + ai * HALF + m * 16) * 3072 + 2048 + col0 + bj * HALF);
#pragma unroll
        for (int ai = 0; ai < 2; ++ai)
#pragma unroll
            for (int m = 0; m < 4; ++m) { const size_t row = (size_t)(row0 + ai * HALF + m * 16);
#pragma unroll
                for (int bj = 0; bj < 2; ++bj) { const u32x4 g = gv[ai][m][bj];
                    const f32x4 g0 = {bf_lo(g.x), bf_hi(g.x), bf_lo(g.y), bf_hi(g.y)}, g1 = {bf_lo(g.z), bf_hi(g.z), bf_lo(g.w), bf_hi(g.w)};
                    constexpr float ms = MIX8_SCALE / (W8_SCALE * 8.0f);
                    u32x2 w; w.x = pack4_fp8(acc[ai][bj][m][0] * g0 * ms); w.y = pack4_fp8(acc[ai][bj][m][1] * g1 * ms); *(u32x2*)((unsigned char*)MIXED + row * 1024 + col0 + bj * HALF) = w; } }
    }
};
struct EpiY {
    static constexpr bool PERM = true, MIDK = false, F8 = true; static constexpr int NST = 0;
    bf16_t* Y; const float* X; const bf16_t* XH;
    __device__ __forceinline__ void operator()(const Acc& acc, const Unit& u, int wr, int wc, int fr, int fq) const {
        const int row0 = u.row0 + wr * 64 + fr, col0 = u.pn * 256 + wc * 32 + 8 * fq;
        constexpr float ds = 1.0f / (W8_SCALE * MIX8_SCALE);
#pragma unroll
        for (int ai = 0; ai < 2; ++ai) {
            f32x4 xr[4][2][2];
#pragma unroll
            for (int m = 0; m < 4; ++m) { const size_t ro = (size_t)(row0 + ai * HALF + m * 16) * 1024 + col0;
#pragma unroll
                for (int bj = 0; bj < 2; ++bj) {
                    if (X) { xr[m][bj][0] = *(const f32x4*)(X + ro + bj * HALF); xr[m][bj][1] = *(const f32x4*)(X + ro + bj * HALF + 4); }
                    else { const u32x4 w = *(const u32x4*)(XH + ro + bj * HALF); xr[m][bj][0] = (f32x4){bf_lo(w.x), bf_hi(w.x), bf_lo(w.y), bf_hi(w.y)}; xr[m][bj][1] = (f32x4){bf_lo(w.z), bf_hi(w.z), bf_lo(w.w), bf_hi(w.w)}; } } }
#pragma unroll
            for (int m = 0; m < 4; ++m) { const size_t ro = (size_t)(row0 + ai * HALF + m * 16) * 1024 + col0;
#pragma unroll
                for (int bj = 0; bj < 2; ++bj) *(u32x4*)(Y + ro + bj * HALF) = pack8(xr[m][bj][0] * DN_ALPHA + acc[ai][bj][m][0] * ds, xr[m][bj][1] * DN_ALPHA + acc[ai][bj][m][1] * ds); } }
    }
};
struct EpiF32 {
    static constexpr bool PERM = false, MIDK = false, F8 = false; static constexpr int NST = 0;
    float* C; int ldc;
    __device__ __forceinline__ void operator()(const Acc& acc, const Unit& u, int wr, int wc, int fr, int fq) const {
        const int row0 = u.row0 + wr * 64 + fr, col0 = u.pn * 256 + wc * 32 + 4 * fq;
#pragma unroll
        for (int ai = 0; ai < 2; ++ai)
#pragma unroll
            for (int m = 0; m < 4; ++m) { float* rowp = C + (size_t)(row0 + ai * HALF + m * 16) * ldc + col0;
#pragma unroll
                for (int bj = 0; bj < 2; ++bj)
#pragma unroll
                    for (int n = 0; n < 2; ++n) *(f32x4*)(rowp + bj * HALF + n * 16) = acc[ai][bj][m][n]; }
    }
};
struct EpiRouter {
    static constexpr bool PERM = false, MIDK = false, F8 = false; static constexpr int NST = 0;
    float* SCT;
    __device__ __forceinline__ void operator()(const Acc& acc, const Unit& u, int wr, int wc, int fr, int fq) const {
        const int row0 = u.row0 + wr * 64 + fr, col0 = u.pn * 256 + wc * 32 + 4 * fq;
#pragma unroll
        for (int ai = 0; ai < 2; ++ai)
#pragma unroll
            for (int m = 0; m < 4; ++m) { const int row = row0 + ai * HALF + m * 16;
#pragma unroll
                for (int bj = 0; bj < 2; ++bj)
#pragma unroll
                    for (int n = 0; n < 2; ++n)
#pragma unroll
                        for (int e = 0; e < 4; ++e) SCT[(size_t)(col0 + bj * HALF + n * 16 + e) * NTOK + row] = 1.0f / (1.0f + expf(-acc[ai][bj][m][n][e])); }
    }
};
struct EpiGU {
    static constexpr bool PERM = true, MIDK = false, F8 = true; static constexpr int NST = 8;
    bf16_t* H; const float* RW; unsigned char* dummy;
    __device__ __forceinline__ void operator()(const Acc& acc, const Unit& u, int wr, int wc, int fr, int fq) const {
        const int lc = u.pn * 128 + wc * 32 + 8 * fq;
        float rw[2][4];
#pragma unroll
        for (int ai = 0; ai < 2; ++ai)
#pragma unroll
            for (int m = 0; m < 4; ++m) { const int rl = ai * HALF + wr * 64 + m * 16 + fr; rw[ai][m] = RW[u.row0 + (rl < u.lim ? rl : u.lim - 1)]; }
#pragma unroll
        for (int ai = 0; ai < 2; ++ai)
#pragma unroll
            for (int m = 0; m < 4; ++m) { const int rl = ai * HALF + wr * 64 + m * 16 + fr;
                { const int row = u.row0 + rl; const float w = rw[ai][m]; f32x4 o[2];
#pragma unroll
                    for (int n = 0; n < 2; ++n)
#pragma unroll
                        for (int e = 0; e < 4; ++e) { const float g = acc[ai][0][m][n][e] * (1.0f / W8_SCALE); o[n][e] = g * fast_sigmoid(g) * (acc[ai][1][m][n][e] * (1.0f / W8_SCALE)) * w; }
                    u32x2 w8; w8.x = pack4_fp8(o[0] * H8_SCALE); w8.y = pack4_fp8(o[1] * H8_SCALE); *(u32x2*)((rl < u.lim) ? (unsigned char*)H + (size_t)row * 256 + lc : dummy + (((wr * 4 + wc) * 64 + fq * 16 + fr) * 8)) = w8; } }
    }
};
constexpr float Y8_SCALE = 8.0f;
__device__ __forceinline__ f32x4 clamp_y8(f32x4 v) {
#pragma unroll
    for (int e = 0; e < 4; ++e) v[e] = __builtin_amdgcn_fmed3f(v[e] * (Y8_SCALE / (W8_SCALE * H8_SCALE)), -440.0f, 440.0f);
    return v; }
struct EpiDown {
    static constexpr bool PERM = true, MIDK = false, F8 = true;
    static constexpr int NST = 8;
    static constexpr float YDIV = W8_SCALE * H8_SCALE / Y8_SCALE;
    static constexpr int XP = 272;
    unsigned char* YS8; LAS unsigned char* xb0; LAS unsigned char* xb1; unsigned char* dummy;
    __device__ __forceinline__ void operator()(const Acc& acc, const Unit& u, int wr, int wc, int fr, int fq) const {
        const int t = (wr * 4 + wc) * 64 + fq * 16 + fr;
        const int wo = (wr * 16 + fr) * XP + wc * 32 + 8 * fq;
        const int rr = t >> 4, rc = (t & 15) * 16, rlb = (rr >> 4) * 64 + (rr & 15);
        unsigned char* gp = YS8 + (size_t)(u.row0 + rlb) * 1024 + u.pn * 256 + rc;
#pragma unroll
        for (int ai = 0; ai < 2; ++ai)
#pragma unroll
            for (int m = 0; m < 4; ++m) { LAS unsigned char* xb = (m & 1) ? xb1 : xb0;
#pragma unroll
                for (int bj = 0; bj < 2; ++bj) { u32x2 w; w.x = pack4_fp8_div(acc[ai][bj][m][0], YDIV); w.y = pack4_fp8_div(acc[ai][bj][m][1], YDIV); *(LAS u32x2*)(xb + wo + bj * HALF) = w; }
                asm volatile("s_waitcnt lgkmcnt(0)" ::: "memory"); __builtin_amdgcn_s_barrier(); asm volatile("" ::: "memory");
                const u32x4 v = *(const LAS u32x4*)(xb + rr * XP + rc);
                unsigned char* sp = (ai * HALF + m * 16 + rlb < u.lim) ? gp + (size_t)(ai * HALF + m * 16) * 1024 : dummy + t * 16;
                *(u32x4*)sp = v; }
    }
};
}

constexpr float OC8_SCALE = 8.0f;
struct AttnPtrs { const bf16_t* QKV; const bf16_t* QM; const bf16_t* KVM; const bf16_t* KR; const float* CUMF; unsigned char* OCAT; };
#define ATT_BAR() asm volatile("s_waitcnt lgkmcnt(0)\n\ts_barrier" ::: "memory")
__device__ __forceinline__ int crow(int i, int hh) { return (i & 3) + 8 * (i >> 2) + 4 * hh; }
__device__ __forceinline__ s16x4 vtr(const LAS unsigned char* p) { return __builtin_bit_cast(s16x4, __builtin_amdgcn_ds_read_tr16_b64_v4i16((LAS s16x4*)p)); }

template <int MODE>
__device__ __forceinline__ void attn_unit(LAS unsigned char* lds, int tid_, int b, int h, int qb, const AttnPtrs& P) {
    constexpr int DQK = (MODE == 2) ? 96 : 64, NKS = DQK / 16, KS = DQK * 2 + 16, VS = 192;
    constexpr int SLOT = 64 * KS + 64 * VS, LC = 2 * SLOT, LF = LC + 8192;
    constexpr float THR = 8.0f;
    const int wid = opaque_s(tid_), lane = lane_now(), tid = wid * 64 + lane, r = lane & 31, hh = lane >> 5;
    const size_t rowbase = (size_t)b * SEQ; const int q0 = qb * 256, qg = q0 + wid * 32 + r;
    const bf16_t* Kg; const bf16_t* Vg; int pitch;
    bf16x8 qf[NKS];
    if (MODE == 2) {
        const bf16_t* qp = P.QM + (rowbase + qg) * 768;
#pragma unroll
        for (int ks = 0; ks < 4; ++ks) qf[ks] = *(const bf16x8*)(qp + h * 64 + ks * 16 + hh * 8);
#pragma unroll
        for (int ks = 4; ks < NKS; ++ks) qf[ks] = *(const bf16x8*)(qp + 512 + h * 32 + (ks - 4) * 16 + hh * 8);
        Kg = P.KVM + rowbase * 1024 + h * 64; Vg = P.KVM + rowbase * 1024 + 512 + h * 64; pitch = 1024;
    } else {
        const int co = (MODE == 1) ? 768 : 0;
        const bf16_t* qp = P.QKV + (rowbase + qg) * 1536 + co + h * 64;
#pragma unroll
        for (int ks = 0; ks < NKS; ++ks) qf[ks] = *(const bf16x8*)(qp + ks * 16 + hh * 8);
        Kg = P.QKV + rowbase * 1536 + co + 256 + h * 64; Vg = P.QKV + rowbase * 1536 + co + 512 + h * 64; pitch = 1536;
    }
    const bf16_t* KRg = P.KR + rowbase * 32;
    float ct = 0.f;
    LAS float* ctab = (LAS float*)(lds + LC);
    if (MODE == 1) {
        const float* cf = P.CUMF + ((size_t)b * 4 + h) * SEQ;
        for (int i = tid; i < q0 + 256; i += NTHREADS) ctab[i] = cf[i];
        ct = cf[qg];
    }
    const int NT = 4 * (qb + 1);
    const int srow = tid >> 3, sch = tid & 7;
    u32x4 kreg, vreg, rreg = (u32x4){0u, 0u, 0u, 0u};
#define ATT_LDT(tt) do { const size_t gr_ = (size_t)((tt) * 64 + srow); \
        kreg = *(const u32x4*)(Kg + gr_ * pitch + sch * 8); vreg = *(const u32x4*)(Vg + gr_ * pitch + sch * 8); \
        if (MODE == 2) { if (tid < 256) rreg = *(const u32x4*)(KRg + (size_t)((tt) * 64 + (tid >> 2)) * 32 + (tid & 3) * 8); } } while (0)
#define ATT_WRT(so) do { *(LAS u32x4*)(lds + (so) + srow * KS + sch * 16) = kreg; *(LAS u32x4*)(lds + (so) + 64 * KS + srow * VS + sch * 16) = vreg; \
        if (MODE == 2) { if (tid < 256) *(LAS u32x4*)(lds + (so) + (tid >> 2) * KS + 128 + (tid & 3) * 16) = rreg; } } while (0)
    f32x16 o[2]; o[0] = f32x16{}; o[1] = f32x16{};
    float mref = 0.f, lrun = 0.f, carry = 0.f; bool wdone = false;
    const int t0 = (MODE == 0) ? NT - 1 : 0, tstep = (MODE == 0) ? -1 : 1;
    ATT_LDT(t0); ATT_WRT(0); if (NT > 1) ATT_LDT(t0 + tstep);
    ATT_BAR();
    const int vrd = (4 * hh + ((lane & 15) >> 2)) * VS + (16 * ((lane >> 4) & 1) + 4 * (lane & 3)) * 2;
    f32x16 negm;
#pragma unroll
    for (int i = 0; i < 16; ++i) negm[i] = ct;
    for (int it = 0; it < NT; ++it) {
        const int t = t0 + tstep * it; const int so = (it & 1) * SLOT;
        if (MODE == 0) {
            if (it > 0) { const LAS unsigned* fl = (const LAS unsigned*)(lds + LF) + 8 * ((it - 1) & 1); unsigned a = fl[0] & fl[1] & fl[2] & fl[3] & fl[4] & fl[5] & fl[6] & fl[7];
                if (__builtin_amdgcn_readfirstlane(a) != 0u) break; } }
        if (it + 1 < NT) { ATT_WRT(SLOT - so); if (it + 2 < NT) ATT_LDT(t + 2 * tstep); }
        const bool wskip = (MODE == 0) && ((t * 64 >= q0 + wid * 32 + 31) || wdone);
        if (!wskip) {
        f32x16 p[2];
        bf16x8 kfr[2][NKS];
#pragma unroll
        for (int kh = 0; kh < 2; ++kh)
#pragma unroll
            for (int ks = 0; ks < NKS; ++ks) kfr[kh][ks] = *(const LAS bf16x8*)(lds + so + (kh * 32 + r) * KS + (ks * 16 + hh * 8) * 2);
        s16x4 vlo[2][2][2], vhi[2][2][2];
#pragma unroll
        for (int kh = 0; kh < 2; ++kh)
#pragma unroll
            for (int s = 0; s < 2; ++s)
#pragma unroll
                for (int db = 0; db < 2; ++db) { const LAS unsigned char* va = lds + so + 64 * KS + (32 * kh + 16 * s) * VS + db * 64 + vrd; vlo[kh][s][db] = vtr(va); vhi[kh][s][db] = vtr(va + 8 * VS); }
#pragma unroll
        for (int kh = 0; kh < 2; ++kh) {
#pragma unroll
            for (int ks = 0; ks < NKS; ++ks) p[kh] = __builtin_amdgcn_mfma_f32_32x32x16_bf16(kfr[kh][ks], qf[ks], ks == 0 ? negm : p[kh], 0, 0, 0); }
        const bool band = (t * 64 + 63 >= q0 + wid * 32);
        if (MODE == 0) {
            f32x16 L[2]; float gs[8], gp[8], base[8];
#pragma unroll
            for (int kh = 0; kh < 2; ++kh)
#pragma unroll
                for (int g = 0; g < 4; ++g) { float s = 0.f;
#pragma unroll
                    for (int e = 0; e < 4; ++e) { const int i = g * 4 + e; const float z = p[kh][i];
                        float l = -(fmaxf(z, 0.f) + __builtin_amdgcn_logf(1.0f + __builtin_amdgcn_exp2f(-fabsf(z))));
                        if (band) { if (t * 64 + kh * 32 + crow(i, hh) >= qg) l = 0.f; }
                        L[kh][i] = l; s += l; }
                    gs[kh * 4 + g] = s; }
#pragma unroll
            for (int m = 0; m < 8; ++m) gp[m] = shx(gs[m], 32);
            float T = carry;
#pragma unroll
            for (int m = 7; m >= 0; --m) { base[m] = T + (hh == 0 ? gp[m] : 0.f); T += gs[m] + gp[m]; }
            carry = T;
#pragma unroll
            for (int kh = 0; kh < 2; ++kh)
#pragma unroll
                for (int g = 0; g < 4; ++g) { float E = base[kh * 4 + g];
#pragma unroll
                    for (int e = 3; e >= 0; --e) { const int i = g * 4 + e; const float l = L[kh][i];
                        float w = __builtin_amdgcn_exp2f(p[kh][i] + l + E);
                        if (band) { if (t * 64 + kh * 32 + crow(i, hh) >= qg) w = 0.f; }
                        p[kh][i] = w; E += l; } }
            wdone = __all(carry < -48.0f);
        } else {
            if (MODE == 1) {
#pragma unroll
                for (int kh = 0; kh < 2; ++kh)
#pragma unroll
                    for (int g = 0; g < 4; ++g) { const f32x4 c4 = *(const LAS f32x4*)(ctab + t * 64 + kh * 32 + 8 * g + 4 * hh);
#pragma unroll
                        for (int e = 0; e < 4; ++e) { const int i = g * 4 + e; p[kh][i] -= c4[e]; } }
                if (band) {
                    asm volatile("" ::: "memory");
#pragma unroll
                    for (int kh = 0; kh < 2; ++kh)
#pragma unroll
                        for (int i = 0; i < 16; ++i) { if (t * 64 + kh * 32 + crow(i, hh) > qg) p[kh][i] = -INFINITY; } }
            } else {
                if (band && t > (qg >> 6)) {
                    asm volatile("" ::: "memory");
#pragma unroll
                    for (int kh = 0; kh < 2; ++kh)
#pragma unroll
                        for (int i = 0; i < 16; ++i) p[kh][i] = -INFINITY; }
            }
            float mx = fmaxf(fmaxf(p[0][0], p[1][0]), p[0][1]);
#pragma unroll
            for (int i = 1; i < 16; ++i) mx = fmaxf(fmaxf(mx, p[0][i]), p[1][i]);
            mx = max32(mx);
            if (it == 0 || __any(mx > THR)) {
                const float d = (it == 0) ? mx : fmaxf(mx, 0.f), f = (it == 0) ? 1.0f : __builtin_amdgcn_exp2f(-d);
                mref += d; lrun *= f; o[0] = o[0] * f; o[1] = o[1] * f;
#pragma unroll
                for (int kh = 0; kh < 2; ++kh)
#pragma unroll
                    for (int i = 0; i < 16; ++i) p[kh][i] -= d;
#pragma unroll
                for (int i = 0; i < 16; ++i) negm[i] = ct - mref;
            }
            float ps = 0.f;
#pragma unroll
            for (int kh = 0; kh < 2; ++kh)
#pragma unroll
                for (int i = 0; i < 16; ++i) { const float e = __builtin_amdgcn_exp2f(p[kh][i]); p[kh][i] = e; ps += e; }
            lrun += ps;
        }
#pragma unroll
        for (int kh = 0; kh < 2; ++kh)
#pragma unroll
            for (int s = 0; s < 2; ++s) {
                u32x4 pw; pw.x = cvt_pk_bf16(p[kh][8 * s + 0], p[kh][8 * s + 1]); pw.y = cvt_pk_bf16(p[kh][8 * s + 2], p[kh][8 * s + 3]);
                pw.z = cvt_pk_bf16(p[kh][8 * s + 4], p[kh][8 * s + 5]); pw.w = cvt_pk_bf16(p[kh][8 * s + 6], p[kh][8 * s + 7]);
                const bf16x8 pb = __builtin_bit_cast(bf16x8, pw);
#pragma unroll
                for (int db = 0; db < 2; ++db) {
                    const s16x4 lo = vlo[kh][s][db], hi = vhi[kh][s][db];
                    const bf16x8 vf = (bf16x8){lo[0], lo[1], lo[2], lo[3], hi[0], hi[1], hi[2], hi[3]};
                    o[db] = __builtin_amdgcn_mfma_f32_32x32x16_bf16(vf, pb, o[db], 0, 0, 0); } }
        }
        if (MODE == 0) { if (lane == 0) ((LAS unsigned*)(lds + LF))[8 * (it & 1) + wid] = wdone ? 1u : 0u; }
        ATT_BAR();
    }
    if (MODE != 0) { const float lt = sum32(lrun); const float inv = 1.0f / lt; o[0] = o[0] * inv; o[1] = o[1] * inv; }
    unsigned char* op = P.OCAT + (rowbase + qg) * 1024 + ((MODE == 0) ? 0 : (MODE == 1) ? 256 : 512) + h * 64;
#pragma unroll
    for (int db = 0; db < 2; ++db)
#pragma unroll
        for (int g = 0; g < 4; ++g) { const f32x4 v4 = {o[db][4 * g + 0] * OC8_SCALE, o[db][4 * g + 1] * OC8_SCALE, o[db][4 * g + 2] * OC8_SCALE, o[db][4 * g + 3] * OC8_SCALE};
            *(unsigned*)(op + db * 32 + 8 * g + 4 * hh) = pg8::pack4_fp8(v4); }
#undef ATT_LDT
#undef ATT_WRT
}

template <int MODE>
__device__ __forceinline__ void attn_unit_sm(LAS unsigned char* lds, int tid_, int b, int h, int qb, const AttnPtrs& P) {
    constexpr int DQK = (MODE == 2) ? 96 : 64, NKS = DQK / 16, KS = DQK * 2 + 16, VS = 192;
    constexpr int SLOT = 64 * KS + 64 * VS, LC = 3 * SLOT;
    constexpr float THR = 8.0f;
    const int wid = opaque_s(tid_), lane = lane_now(), tid = wid * 64 + lane, r = lane & 31, hh = lane >> 5;
    const size_t rowbase = (size_t)b * SEQ; const int q0 = qb * 256, qg = q0 + wid * 32 + r;
    const bf16_t* Kg; const bf16_t* Vg; int pitch;
    bf16x8 qf[NKS];
    if (MODE == 2) {
        const bf16_t* qp = P.QM + (rowbase + qg) * 768;
#pragma unroll
        for (int ks = 0; ks < 4; ++ks) qf[ks] = *(const bf16x8*)(qp + h * 64 + ks * 16 + hh * 8);
#pragma unroll
        for (int ks = 4; ks < NKS; ++ks) qf[ks] = *(const bf16x8*)(qp + 512 + h * 32 + (ks - 4) * 16 + hh * 8);
        Kg = P.KVM + rowbase * 1024 + h * 64; Vg = P.KVM + rowbase * 1024 + 512 + h * 64; pitch = 1024;
    } else {
        const bf16_t* qp = P.QKV + (rowbase + qg) * 1536 + 768 + h * 64;
#pragma unroll
        for (int ks = 0; ks < NKS; ++ks) qf[ks] = *(const bf16x8*)(qp + ks * 16 + hh * 8);
        Kg = P.QKV + rowbase * 1536 + 768 + 256 + h * 64; Vg = P.QKV + rowbase * 1536 + 768 + 512 + h * 64; pitch = 1536;
    }
    const bf16_t* KRg = P.KR + rowbase * 32;
    float ct = 0.f;
    LAS float* ctab = (LAS float*)(lds + LC);
    if (MODE == 1) {
        const float* cf = P.CUMF + ((size_t)b * 4 + h) * SEQ;
        for (int i = tid; i < q0 + 256; i += NTHREADS) ctab[i] = cf[i];
        ct = cf[qg];
    }
    const int NT = 4 * (qb + 1);
    const int cw = (q0 + wid * 32 + 31) >> 6;
    const int srow = tid >> 3, sch = tid & 7;
    u32x4 kreg, vreg, rreg = (u32x4){0u, 0u, 0u, 0u};
#define ATT_LDT(tt) do { const size_t gr_ = (size_t)((tt) * 64 + srow); \
        kreg = *(const u32x4*)(Kg + gr_ * pitch + sch * 8); vreg = *(const u32x4*)(Vg + gr_ * pitch + sch * 8); \
        if (MODE == 2) { if (tid < 256) rreg = *(const u32x4*)(KRg + (size_t)((tt) * 64 + (tid >> 2)) * 32 + (tid & 3) * 8); } } while (0)
#define ATT_WRT(so) do { *(LAS u32x4*)(lds + (so) + srow * KS + sch * 16) = kreg; *(LAS u32x4*)(lds + (so) + 64 * KS + srow * VS + sch * 16) = vreg; \
        if (MODE == 2) { if (tid < 256) *(LAS u32x4*)(lds + (so) + (tid >> 2) * KS + 128 + (tid & 3) * 16) = rreg; } } while (0)
#define ATT_QK(dst, so) do { bf16x8 kfr_[2][NKS]; \
        _Pragma("unroll") for (int kh = 0; kh < 2; ++kh) _Pragma("unroll") for (int ks = 0; ks < NKS; ++ks) kfr_[kh][ks] = *(const LAS bf16x8*)(lds + (so) + (kh * 32 + r) * KS + (ks * 16 + hh * 8) * 2); \
        _Pragma("unroll") for (int kh = 0; kh < 2; ++kh) _Pragma("unroll") for (int ks = 0; ks < NKS; ++ks) dst[kh] = __builtin_amdgcn_mfma_f32_32x32x16_bf16(kfr_[kh][ks], qf[ks], ks == 0 ? negm : dst[kh], 0, 0, 0); } while (0)
    f32x16 o[2]; o[0] = f32x16{}; o[1] = f32x16{};
    float mref = 0.f;
    f32x16 negm;
#pragma unroll
    for (int i = 0; i < 16; ++i) negm[i] = ct;
    ATT_LDT(0); ATT_WRT(0); ATT_LDT(1); ATT_WRT(SLOT); ATT_LDT(2);
    ATT_BAR();
    const int vrd = (4 * hh + ((lane & 15) >> 2)) * VS + (16 * ((lane >> 4) & 1) + 4 * (lane & 3)) * 2;
    f32x16 pa[2], pb2[2];
    f32x16 o2 = f32x16{};
    const bf16x8 ones = (bf16x8){(short)0x3F80, (short)0x3F80, (short)0x3F80, (short)0x3F80, (short)0x3F80, (short)0x3F80, (short)0x3F80, (short)0x3F80};
    ATT_QK(pa, 0);
    int sc = 0, sn = SLOT, sw = 2 * SLOT;
#define ATT_STEP(PC, PN, t) do { \
        if ((t) + 2 < NT) { ATT_WRT(sw); if ((t) + 3 < NT) ATT_LDT((t) + 3); } \
        if ((t) <= cw) { \
            if ((t) + 1 <= cw && (t) + 1 < NT) ATT_QK(PN, sn); \
            s16x4 vlo[2][2][2], vhi[2][2][2]; \
            _Pragma("unroll") for (int kh = 0; kh < 2; ++kh) _Pragma("unroll") for (int s = 0; s < 2; ++s) _Pragma("unroll") for (int db = 0; db < 2; ++db) { \
                const LAS unsigned char* va = lds + sc + 64 * KS + (32 * kh + 16 * s) * VS + db * 64 + vrd; vlo[kh][s][db] = vtr(va); vhi[kh][s][db] = vtr(va + 8 * VS); } \
            const bool band = ((t) * 64 + 63 >= q0 + wid * 32); \
            if (MODE == 1) { \
                _Pragma("unroll") for (int kh = 0; kh < 2; ++kh) _Pragma("unroll") for (int g = 0; g < 4; ++g) { const f32x4 c4 = *(const LAS f32x4*)(ctab + (t) * 64 + kh * 32 + 8 * g + 4 * hh); \
                    _Pragma("unroll") for (int e = 0; e < 4; ++e) PC[kh][g * 4 + e] -= c4[e]; } \
                if (band) { asm volatile("" ::: "memory"); \
                    _Pragma("unroll") for (int kh = 0; kh < 2; ++kh) _Pragma("unroll") for (int i = 0; i < 16; ++i) { if ((t) * 64 + kh * 32 + crow(i, hh) > qg) PC[kh][i] = -INFINITY; } } \
            } \
            float mx = fmaxf(fmaxf(PC[0][0], PC[1][0]), PC[0][1]); \
            _Pragma("unroll") for (int i = 1; i < 16; ++i) mx = fmaxf(fmaxf(mx, PC[0][i]), PC[1][i]); \
            mx = max32(mx); \
            if ((t) == 0 || __any(mx > THR)) { \
                const float d = ((t) == 0) ? mx : fmaxf(mx, 0.f), f = ((t) == 0) ? 1.0f : __builtin_amdgcn_exp2f(-d); \
                mref += d; o2 = o2 * f; o[0] = o[0] * f; o[1] = o[1] * f; \
                _Pragma("unroll") for (int kh = 0; kh < 2; ++kh) _Pragma("unroll") for (int i = 0; i < 16; ++i) { PC[kh][i] -= d; PN[kh][i] -= d; } \
                _Pragma("unroll") for (int i = 0; i < 16; ++i) negm[i] = ct - mref; \
            } \
            _Pragma("unroll") for (int kh = 0; kh < 2; ++kh) _Pragma("unroll") for (int i = 0; i < 16; ++i) PC[kh][i] = __builtin_amdgcn_exp2f(PC[kh][i]); \
            _Pragma("unroll") for (int kh = 0; kh < 2; ++kh) _Pragma("unroll") for (int s = 0; s < 2; ++s) { \
                u32x4 pw; pw.x = cvt_pk_bf16(PC[kh][8 * s + 0], PC[kh][8 * s + 1]); pw.y = cvt_pk_bf16(PC[kh][8 * s + 2], PC[kh][8 * s + 3]); \
                pw.z = cvt_pk_bf16(PC[kh][8 * s + 4], PC[kh][8 * s + 5]); pw.w = cvt_pk_bf16(PC[kh][8 * s + 6], PC[kh][8 * s + 7]); \
                const bf16x8 pb = __builtin_bit_cast(bf16x8, pw); \
                o2 = __builtin_amdgcn_mfma_f32_32x32x16_bf16(ones, pb, o2, 0, 0, 0); \
                _Pragma("unroll") for (int db = 0; db < 2; ++db) { const s16x4 lo = vlo[kh][s][db], hi = vhi[kh][s][db]; \
                    const bf16x8 vf = (bf16x8){lo[0], lo[1], lo[2], lo[3], hi[0], hi[1], hi[2], hi[3]}; \
                    o[db] = __builtin_amdgcn_mfma_f32_32x32x16_bf16(vf, pb, o[db], 0, 0, 0); } } \
        } \
        ATT_BAR(); \
        { const int tmp_ = sc; sc = sn; sn = sw; sw = tmp_; } } while (0)
    for (int t = 0; t < NT; t += 2) { ATT_STEP(pa, pb2, t); ATT_STEP(pb2, pa, t + 1); }
#undef ATT_STEP
    { const float inv = 1.0f / o2[0]; o[0] = o[0] * inv; o[1] = o[1] * inv; }
    unsigned char* op = P.OCAT + (rowbase + qg) * 1024 + ((MODE == 1) ? 256 : 512) + h * 64;
#pragma unroll
    for (int db = 0; db < 2; ++db)
#pragma unroll
        for (int g = 0; g < 4; ++g) { const f32x4 v4 = {o[db][4 * g + 0] * OC8_SCALE, o[db][4 * g + 1] * OC8_SCALE, o[db][4 * g + 2] * OC8_SCALE, o[db][4 * g + 3] * OC8_SCALE};
            *(unsigned*)(op + db * 32 + 8 * g + 4 * hh) = pg8::pack4_fp8(v4); }
#undef ATT_LDT
#undef ATT_WRT
#undef ATT_QK
}

__device__ __forceinline__ void attn_item(LAS unsigned char* lds, int tid_, const AttnPtrs& P, int item, int k) {
    if (item < 256) { const int bh = item >> 2, s = item & 3; attn_unit<0>(lds, tid_, bh >> 2, bh & 3, k ? s : 7 - s, P); }
    else if (item < 512) { const int j = item - 256, bh = j >> 2, s = j & 3; attn_unit_sm<1>(lds, tid_, bh >> 2, bh & 3, k ? s : 7 - s, P); }
    else { const int j = item - 512, bh = j >> 2, s = j & 3; attn_unit_sm<2>(lds, tid_, bh >> 3, bh & 7, k ? s : 7 - s, P); }
}

struct Frame { LAS unsigned char* lds; int tid, lane, wave, vcu, G, gw, NGW; };
typedef const __attribute__((address_space(4))) unsigned char* kargp_t;
__device__ __forceinline__ kargp_t karg_base() { kargp_t p = (kargp_t)__builtin_amdgcn_kernarg_segment_ptr(); asm volatile("" : "+s"(p)); return p; }
__device__ __forceinline__ const float* karg_in(kargp_t kp, int i) { return *(const float* const __attribute__((address_space(4)))*)(kp + 8 * i); }
__device__ __forceinline__ float* karg_out(kargp_t kp) { return *(float* const __attribute__((address_space(4)))*)(kp + 192); }
__device__ __forceinline__ unsigned char* karg_ws(kargp_t kp) { return *(unsigned char* const __attribute__((address_space(4)))*)(kp + 200); }
#define LDS_WAIT() asm volatile("s_waitcnt lgkmcnt(0)" ::: "memory")

__device__ __forceinline__ int srccol(int mode, int n) {
    switch (mode) {
    case 1:
        if (n < 1536) return n;
        if (n < 1792) return OFF_DQ + (n - 1536);
        if (n < 1920) return OFF_DKV + (n - 1792);
        if (n < 1952) return OFF_KR + (n - 1920);
        if (n < 1956) return OFF_FGATE + (n - 1952);
        if (n < 2048) return -1;
        return OFF_GATE + (n - 2048);
    case 2:
        if (n < 512) return (n >> 6) * 96 + (n & 63);
        return ((n - 512) >> 5) * 96 + 64 + ((n - 512) & 31);
    case 3:
        if (n < 512) return (n >> 6) * 128 + (n & 63);
        return ((n - 512) >> 6) * 128 + 64 + ((n - 512) & 63);
    case 6: return OFF_GATE + n;
    case 4:
        return 128 * (n >> 8) + (n & 127);
    default: return n;
    }
}
struct TJob { const float* src; const float* src2; int ldw, Ksrc, K, Nd, mode; const float* kscale; bf16_t* dst; int dld; int f8; };
__device__ __forceinline__ void titem_load(const TJob& J, int item, int lane, float (&v)[32]) {
    const int nblk = J.Nd / 32, kb = item / nblk, nb = item % nblk, k0 = 64 * kb, n0 = 32 * nb;
    const int n = n0 + (lane & 31); const int sc = srccol(J.mode, n);
    const float* S = (J.mode == 4 && ((n >> 7) & 1)) ? J.src2 : J.src;
#pragma unroll
    for (int i = 0; i < 32; ++i) { const int k = k0 + 2 * i + (lane >> 5); v[i] = (sc >= 0 && k < J.Ksrc) ? __builtin_nontemporal_load(S + (size_t)k * J.ldw + sc) : 0.f; }
}
__device__ __forceinline__ void titem_load4(const TJob& J, int item, int lane, float (&v)[32]) {
    const int nblk = J.Nd / 32, kb = item / nblk, nb = item % nblk, k0 = 64 * kb, n0 = 32 * nb;
    const int n = n0 + 4 * (lane & 7); const int sc = srccol(J.mode, n);
    const float* S = (J.mode == 4 && ((n >> 7) & 1)) ? J.src2 : J.src;
#pragma unroll
    for (int i = 0; i < 8; ++i) { const f32x4 q = __builtin_nontemporal_load((const f32x4*)(S + (size_t)(k0 + 8 * i + (lane >> 3)) * J.ldw + sc));
        v[4 * i + 0] = q[0]; v[4 * i + 1] = q[1]; v[4 * i + 2] = q[2]; v[4 * i + 3] = q[3]; }
}
template <bool X4 = false>
__device__ __forceinline__ void titem_store(const TJob& J, LAS float* scr, int item, int lane, float (&v)[32]) {
    const int nblk = J.Nd / 32, kb = item / nblk, nb = item % nblk, k0 = 64 * kb, n0 = 32 * nb;
    if (!X4 && J.kscale) {
#pragma unroll
        for (int i = 0; i < 32; ++i) { const int k = k0 + 2 * i + (lane >> 5); if (k < J.Ksrc) v[i] *= J.kscale[k]; } }
    if constexpr (X4) {
#pragma unroll
        for (int i = 0; i < 8; ++i)
#pragma unroll
            for (int e = 0; e < 4; ++e) scr[(8 * i + (lane >> 3)) * 33 + 4 * (lane & 7) + e] = v[4 * i + e];
    } else
#pragma unroll
    for (int i = 0; i < 32; ++i) scr[(2 * i + (lane >> 5)) * 33 + (lane & 31)] = v[i];
    LDS_WAIT(); asm volatile("" ::: "memory");
    if (J.f8) {
        const int c4 = lane & 3;
#pragma unroll
        for (int j = 0; j < 2; ++j) { const int nn = (lane >> 2) + 16 * j; const LAS float* s = scr + (16 * c4) * 33 + nn; u32x4 o;
#pragma unroll
            for (int q = 0; q < 4; ++q) { int w = __builtin_amdgcn_cvt_pk_fp8_f32(s[(4 * q + 0) * 33] * 32.0f, s[(4 * q + 1) * 33] * 32.0f, 0, false);
                w = __builtin_amdgcn_cvt_pk_fp8_f32(s[(4 * q + 2) * 33] * 32.0f, s[(4 * q + 3) * 33] * 32.0f, w, true); o[q] = (unsigned)w; }
            *(u32x4*)((unsigned char*)J.dst + (size_t)(n0 + nn) * J.dld + k0 + 16 * c4) = o; }
        LDS_WAIT(); asm volatile("" ::: "memory"); return; }
    const int c = lane & 7;
#pragma unroll
    for (int j = 0; j < 4; ++j) { const int nn = (lane >> 3) + 8 * j; const LAS float* s = scr + (8 * c) * 33 + nn;
        u32x4 o; o.x = cvt_pk_bf16(s[0 * 33], s[1 * 33]); o.y = cvt_pk_bf16(s[2 * 33], s[3 * 33]); o.z = cvt_pk_bf16(s[4 * 33], s[5 * 33]); o.w = cvt_pk_bf16(s[6 * 33], s[7 * 33]);
        *(u32x4*)(J.dst + (size_t)(n0 + nn) * J.dld + k0 + 8 * c) = o; }
    LDS_WAIT(); asm volatile("" ::: "memory");
}
__device__ __forceinline__ void transpose_item(const TJob& J, LAS float* scr, int item, int lane) { float v[32]; titem_load(J, item, lane, v); titem_store(J, scr, item, lane, v); }
__device__ __forceinline__ void run_job(const Frame& F, const TJob& J) {
    LAS float* scr = (LAS float*)(F.lds + F.wave * 16384);
    const int nitems = (J.K / 64) * (J.Nd / 32);
    for (int it = F.gw; it < nitems; it += F.NGW) transpose_item(J, scr, it, F.lane);
}
__device__ __forceinline__ void convert_small_weights(const Frame& F, kargp_t kp, unsigned char* ws, int l) {
    unsigned char* wb = ws + WS_WSMALL + (size_t)l * WSMALL_LAYER;
    TJob J;
    J.src2 = nullptr; J.kscale = nullptr; J.f8 = 0;
    J.src = karg_in(kp, 5) + (size_t)l * DM * IN_WIDTH; J.ldw = IN_WIDTH; J.Ksrc = 1024; J.K = 1024; J.Nd = 2048; J.mode = 1; J.dst = (bf16_t*)(wb + WOF_IN); J.dld = 1024; J.f8 = 1; run_job(F, J); J.f8 = 0;
    J.Nd = 3072; J.mode = 6; J.dst = (bf16_t*)(wb + WOF_IN + 4 * MiB); J.f8 = 1; run_job(F, J); J.f8 = 0;
    J.src = karg_in(kp, 9) + (size_t)l * 256 * 768; J.ldw = 768; J.Ksrc = 256; J.K = 256; J.Nd = 768; J.mode = 2; J.kscale = karg_in(kp, 8) + l * 256; J.dst = (bf16_t*)(wb + WOF_UQ); J.dld = 256; run_job(F, J);
    J.src = karg_in(kp, 11) + (size_t)l * 128 * 1024; J.ldw = 1024; J.Ksrc = 128; J.K = 256; J.Nd = 1024; J.mode = 3; J.kscale = karg_in(kp, 10) + l * 128; J.dst = (bf16_t*)(wb + WOF_UKV); J.dld = 256; run_job(F, J);
    J.kscale = nullptr; J.mode = 0;
    J.f8 = 1;
    J.src = karg_in(kp, 12) + (size_t)l * 256 * 1024; J.ldw = 1024; J.Ksrc = 256; J.K = 256; J.Nd = 1024; J.dst = (bf16_t*)(wb + WOF_PSB); J.dld = 1024; run_job(F, J);
    J.src = karg_in(kp, 13) + (size_t)l * 256 * 1024; J.dst = (bf16_t*)(wb + WOF_PSB + 256); run_job(F, J);
    J.src = karg_in(kp, 14) + (size_t)l * 512 * 1024; J.Ksrc = 512; J.K = 512; J.dst = (bf16_t*)(wb + WOF_PSB + 512); run_job(F, J);
    J.f8 = 0;
    J.src = karg_in(kp, 15) + (size_t)l * 1024 * 1024; J.Ksrc = 1024; J.K = 1024; J.dst = (bf16_t*)(wb + WOF_OUT3); J.dld = 1024; J.f8 = 1; run_job(F, J); J.f8 = 0;
    J.src = karg_in(kp, 16) + (size_t)l * 1024 * 256; J.ldw = 256; J.Nd = 256; J.dst = (bf16_t*)(wb + WOF_R); J.dld = 1024; run_job(F, J);
}
__device__ __forceinline__ void expert_job(kargp_t kp, unsigned char* ws, int l, int it, TJob& J, int& sub) {
    if (it < NE1 * 256) { const int e = it >> 8; sub = it & 255;
        if (e < NEXP) { J.src = karg_in(kp, 18) + ((size_t)l * NEXP + e) * 1024 * 256; J.src2 = karg_in(kp, 19) + ((size_t)l * NEXP + e) * 1024 * 256; }
        else { J.src = karg_in(kp, 21) + (size_t)l * 1024 * 256; J.src2 = karg_in(kp, 22) + (size_t)l * 1024 * 256; }
        J.ldw = 256; J.Ksrc = 1024; J.K = 1024; J.Nd = 512; J.mode = 4; J.kscale = nullptr; J.dst = (bf16_t*)(ws + WS_WGU + (size_t)e * 512 * 1024); J.dld = 1024; J.f8 = 1;
    } else { const int q = it - NE1 * 256, e = q >> 7; sub = q & 127;
        J.src = (e < NEXP) ? karg_in(kp, 20) + ((size_t)l * NEXP + e) * 256 * 1024 : karg_in(kp, 23) + (size_t)l * 256 * 1024; J.src2 = nullptr;
        J.ldw = 1024; J.Ksrc = 256; J.K = 256; J.Nd = 1024; J.mode = 0; J.kscale = nullptr; J.dst = (bf16_t*)(ws + WS_WD + (size_t)e * 1024 * 256); J.dld = 256; J.f8 = 1; }
}
__device__ __forceinline__ void convert_expert_weights(const Frame& F, kargp_t kp, unsigned char* ws, int l) {
    LAS float* scr = (LAS float*)(F.lds + F.wave * 16384);
    constexpr int NIT = NE1 * 256 + NE1 * 128;
    float va[32], vb[32]; TJob Ja, Jb; int sa = 0, sb = 0; int it = F.gw;
    if (it < NIT) { expert_job(kp, ws, l, it, Ja, sa); titem_load4(Ja, sa, F.lane, va); }
    while (it < NIT) {
        const int itn = it + F.NGW; const bool hn = itn < NIT;
        if (hn) { expert_job(kp, ws, l, itn, Jb, sb); titem_load4(Jb, sb, F.lane, vb); }
        titem_store<true>(Ja, scr, sa, F.lane, va);
        if (hn) { Ja = Jb; sa = sb;
#pragma unroll
            for (int i = 0; i < 32; ++i) va[i] = vb[i]; }
        it = itn;
    }
}
__device__ __forceinline__ void build_rope(const Frame& F, unsigned char* ws) {
    float* rc = (float*)(ws + WS_ROPE); float* rs = rc + SEQ * 16;
    for (int idx = F.gw * 64 + F.lane; idx < SEQ * 16; idx += F.NGW * 64) { const int pos = idx >> 4, i = idx & 15;
        const float inv = exp2f(-(float)i * (13.287712379549449f / 16.0f));
        const float ang = (float)pos * inv;
        double rev = (double)ang * 0.15915494309189535; rev -= floor(rev);
        rc[idx] = __builtin_amdgcn_cosf((float)rev); rs[idx] = __builtin_amdgcn_sinf((float)rev); }
}
__device__ __forceinline__ void convert_x(const Frame& F, const float* x, bf16_t* xb, unsigned char* x8) {
    for (size_t i = (size_t)F.gw * 64 + F.lane; i < (size_t)NTOK * DM / 8; i += (size_t)F.NGW * 64) {
        const f32x4 a = *(const f32x4*)(x + i * 8), b = *(const f32x4*)(x + i * 8 + 4);
        *(u32x4*)(xb + i * 8) = pg8::pack8(a, b); u32x2 w8; w8.x = pg8::pack4_fp8(a); w8.y = pg8::pack4_fp8(b); *(u32x2*)(x8 + i * 8) = w8; }
}
__device__ __forceinline__ void cumf_phase(const Frame& F, unsigned char* ws) {
    const float* LOGF = (const float*)(ws + WS_LOGF); float* CUMF = (float*)(ws + WS_CUMF);
    for (int seq = F.gw; seq < NBATCH * 4; seq += F.NGW) { const int b = seq >> 2, h = seq & 3;
        float v[32]; float s = 0.f;
#pragma unroll
        for (int j = 0; j < 32; ++j) { s += LOGF[((size_t)b * SEQ + F.lane * 32 + j) * 4 + h]; v[j] = s; }
        float inc = s;
#pragma unroll
        for (int o = 1; o < 64; o <<= 1) { const float u = shup(inc, o); if (F.lane >= o) inc += u; }
        const float ex = inc - s;
#pragma unroll
        for (int j = 0; j < 32; ++j) CUMF[(size_t)seq * SEQ + F.lane * 32 + j] = v[j] + ex; }
}
__device__ __forceinline__ void ln_store(const Frame& F, f32x4 (&v)[4], const float* g, const float* bb, float* orow, bf16_t* obrow, unsigned char* o8row = nullptr) {
    float s = 0.f;
#pragma unroll
    for (int j = 0; j < 4; ++j) s += (v[j][0] + v[j][1]) + (v[j][2] + v[j][3]);
    const float mean = wave_sum(s) * (1.0f / DM); float s2 = 0.f;
#pragma unroll
    for (int j = 0; j < 4; ++j) { v[j] = v[j] - mean; s2 += (v[j][0] * v[j][0] + v[j][1] * v[j][1]) + (v[j][2] * v[j][2] + v[j][3] * v[j][3]); }
    const float rstd = 1.0f / sqrtf(wave_sum(s2) * (1.0f / DM) + LN_EPS);
#pragma unroll
    for (int j = 0; j < 4; ++j) { const int c = 256 * j + 4 * F.lane; const f32x4 gv = *(const f32x4*)(g + c), bv = *(const f32x4*)(bb + c);
        const f32x4 y = v[j] * rstd * gv + bv; if (orow) *(f32x4*)(orow + c) = y;
        if (obrow) { u32x2 w; w.x = cvt_pk_bf16(y[0], y[1]); w.y = cvt_pk_bf16(y[2], y[3]); *(u32x2*)(obrow + c) = w; }
        if (o8row) *(unsigned*)(o8row + c) = pg8::pack4_fp8(y); }
}
__device__ __forceinline__ void ln1_phase(const Frame& F, const bf16_t* Y, const float* g, const float* bb, float* STATS, bf16_t* X1B, unsigned char* X1F8) {
    f32x4 gv[2][2], bv[2][2];
#pragma unroll
    for (int j = 0; j < 2; ++j)
#pragma unroll
        for (int q = 0; q < 2; ++q) { gv[j][q] = *(const f32x4*)(g + 512 * j + 8 * F.lane + 4 * q); bv[j][q] = *(const f32x4*)(bb + 512 * j + 8 * F.lane + 4 * q); }
    for (int r0 = F.gw * 4; r0 < NTOK; r0 += F.NGW * 4) {
        u32x4 w[4][2];
#pragma unroll
        for (int k = 0; k < 4; ++k)
#pragma unroll
            for (int j = 0; j < 2; ++j) w[k][j] = *(const u32x4*)(Y + (size_t)(r0 + k) * DM + 512 * j + 8 * F.lane);
#pragma unroll
        for (int k = 0; k < 4; ++k) { f32x4 v[2][2]; float s = 0.f;
#pragma unroll
            for (int j = 0; j < 2; ++j) { v[j][0] = (f32x4){bf_lo(w[k][j].x), bf_hi(w[k][j].x), bf_lo(w[k][j].y), bf_hi(w[k][j].y)}; v[j][1] = (f32x4){bf_lo(w[k][j].z), bf_hi(w[k][j].z), bf_lo(w[k][j].w), bf_hi(w[k][j].w)};
                s += ((v[j][0][0] + v[j][0][1]) + (v[j][0][2] + v[j][0][3])) + ((v[j][1][0] + v[j][1][1]) + (v[j][1][2] + v[j][1][3])); }
            const float mean = wave_sum(s) * (1.0f / DM); float s2 = 0.f;
#pragma unroll
            for (int j = 0; j < 2; ++j)
#pragma unroll
                for (int q = 0; q < 2; ++q) { v[j][q] = v[j][q] - mean; s2 += (v[j][q][0] * v[j][q][0] + v[j][q][1] * v[j][q][1]) + (v[j][q][2] * v[j][q][2] + v[j][q][3] * v[j][q][3]); }
            const float rstd = 1.0f / sqrtf(wave_sum(s2) * (1.0f / DM) + LN_EPS);
            if (F.lane == 0) *(f32x2*)(STATS + (size_t)(r0 + k) * 2) = (f32x2){mean, rstd};
#pragma unroll
            for (int j = 0; j < 2; ++j) { const f32x4 y0 = v[j][0] * rstd * gv[j][0] + bv[j][0], y1 = v[j][1] * rstd * gv[j][1] + bv[j][1]; const size_t o = (size_t)(r0 + k) * DM + 512 * j + 8 * F.lane;
                *(u32x4*)(X1B + o) = pg8::pack8(y0, y1); u32x2 w8; w8.x = pg8::pack4_fp8(y0); w8.y = pg8::pack4_fp8(y1); *(u32x2*)(X1F8 + o) = w8; } }
    }
}
__device__ __forceinline__ void combine_phase(const Frame& F, const bf16_t* Y, const float* STATS, const float* g1, const float* b1, const unsigned char* YS8, const int* INV, const float* g, const float* bb, float* XO, bf16_t* XOB, unsigned char* XO8) {
    for (int row = F.gw; row < NTOK; row += F.NGW) { f32x4 v[4], s[4]; const f32x2 st = *(const f32x2*)(STATS + (size_t)row * 2);
#pragma unroll
        for (int j = 0; j < 4; ++j) { const int c = 256 * j + 4 * F.lane; const u32x2 yw = *(const u32x2*)(Y + (size_t)row * DM + c); const f32x4 yv = {bf_lo(yw.x), bf_hi(yw.x), bf_lo(yw.y), bf_hi(yw.y)};
            v[j] = ((yv - st[0]) * st[1] * *(const f32x4*)(g1 + c) + *(const f32x4*)(b1 + c)) * DN_ALPHA; s[j] = (f32x4){0.f, 0.f, 0.f, 0.f}; }
#pragma unroll
        for (int k = 0; k <= TOPK; ++k) { const size_t sr = (k < TOPK) ? (size_t)INV[row * TOPK + k] : (size_t)NASSIGN + row;
#pragma unroll
            for (int j = 0; j < 4; ++j) { const int w = *(const int*)(YS8 + sr * DM + 256 * j + 4 * F.lane);
                s[j][0] += __builtin_amdgcn_cvt_f32_fp8(w, 0); s[j][1] += __builtin_amdgcn_cvt_f32_fp8(w, 1); s[j][2] += __builtin_amdgcn_cvt_f32_fp8(w, 2); s[j][3] += __builtin_amdgcn_cvt_f32_fp8(w, 3); } }
#pragma unroll
        for (int j = 0; j < 4; ++j) v[j] = v[j] + s[j] * (1.0f / pg8::Y8_SCALE);
        ln_store(F, v, g, bb, XO ? XO + (size_t)row * DM : nullptr, XOB ? XOB + (size_t)row * DM : nullptr, XOB ? XO8 + (size_t)row * DM : nullptr); }
}
__device__ __forceinline__ void route_phase(const Frame& F, const float* SCT, const float* rbias, int* EI, float* TKW, unsigned* cnt) {
    LAS unsigned* hist = (LAS unsigned*)(F.lds);
    for (int blk = F.vcu; blk < NTOK / 128; blk += F.G) {
        if (F.tid < 512) hist[F.tid] = 0u;
        __syncthreads();
        int ek[4]; float wk[4]; unsigned lk[4]; const int hf = F.lane >> 5; const int t = blk * 128 + F.wave * 32 + (F.lane & 31);
        if (F.wave < 4) {
            float gsc[4];
#pragma unroll
            for (int gl = 0; gl < 4; ++gl) { const int e0 = 128 * hf + 32 * gl; float m1 = -INFINITY, m2 = -INFINITY;
#pragma unroll 8
                for (int j = 0; j < 32; ++j) { const float v = SCT[(size_t)(e0 + j) * NTOK + t] + rbias[e0 + j]; m2 = fmaxf(m2, fminf(m1, v)); m1 = fmaxf(m1, v); }
                gsc[gl] = m1 + m2; }
            float og[4];
#pragma unroll
            for (int gl = 0; gl < 4; ++gl) og[gl] = shx(gsc[gl], 32);
            bool keep[4];
#pragma unroll
            for (int gl = 0; gl < 4; ++gl) { int rank = 0;
#pragma unroll
                for (int q = 0; q < 4; ++q) { rank += (q != gl && (gsc[q] > gsc[gl] || (gsc[q] == gsc[gl] && q < gl))) ? 1 : 0;
                    rank += (og[q] > gsc[gl] || (og[q] == gsc[gl] && hf == 1)) ? 1 : 0; }
                keep[gl] = rank < 4; }
            float bv[8], sv[8]; int ev[8];
#pragma unroll
            for (int k = 0; k < 8; ++k) { bv[k] = -INFINITY; sv[k] = 0.f; ev[k] = 0; }
#pragma unroll
            for (int gl = 0; gl < 4; ++gl) { const int e0 = 128 * hf + 32 * gl;
                if (__any(keep[gl])) {
#pragma unroll 4
                    for (int j = 0; j < 32; ++j) { const float s = SCT[(size_t)(e0 + j) * NTOK + t]; const float b = keep[gl] ? s + rbias[e0 + j] : -INFINITY;
                        if (__any(b > bv[7])) {
                            if (b > bv[7]) { bv[7] = b; sv[7] = s; ev[7] = e0 + j; }
#pragma unroll
                            for (int k = 7; k > 0; --k) { const bool sw = bv[k] > bv[k - 1];
                                const float tb = sw ? bv[k - 1] : bv[k], ts = sw ? sv[k - 1] : sv[k]; const int te = sw ? ev[k - 1] : ev[k];
                                bv[k - 1] = sw ? bv[k] : bv[k - 1]; sv[k - 1] = sw ? sv[k] : sv[k - 1]; ev[k - 1] = sw ? ev[k] : ev[k - 1];
                                bv[k] = tb; sv[k] = ts; ev[k] = te; } } } } }
            float wsum = 0.f;
#pragma unroll
            for (int k = 0; k < 8; ++k) { const float ob = shx(bv[7 - k], 32), os = shx(sv[7 - k], 32); const int oe = shx(ev[7 - k], 32);
                const bool mine = (bv[k] > ob) || (bv[k] == ob && ev[k] < oe);
                const float cs = mine ? sv[k] : os; const int ce = mine ? ev[k] : oe; wsum += cs;
                if (k < 4) { ek[k] = ce; wk[k] = cs; } }
#pragma unroll
            for (int k = 0; k < 4; ++k) { wk[k] = wk[k] / wsum * ROUTED_SCALE; lk[k] = __hip_atomic_fetch_add(&hist[ek[k]], 1u, __ATOMIC_RELAXED, __HIP_MEMORY_SCOPE_WORKGROUP); }
        }
        __syncthreads();
        if (F.tid < NEXP) { const unsigned h = hist[F.tid]; hist[256 + F.tid] = h ? atomicAdd(cnt + F.tid, h) : 0u; }
        __syncthreads();
        if (F.wave < 4) {
#pragma unroll
            for (int k = 0; k < 4; ++k) { const int a = t * TOPK + 4 * hf + k; EI[a] = (int)(((hist[256 + ek[k]] + lk[k]) << 8) | (unsigned)ek[k]); TKW[a] = wk[k]; } }
        __syncthreads();
    }
}
__device__ __forceinline__ void moe_tables(const Frame& F, unsigned* cnt) {
    LAS int* ustart = (LAS int*)(F.lds + LDS_TAB); LAS int* eoff = ustart + 264; LAS int* ecnt = eoff + 264;
    if (F.tid < NE1) ecnt[F.tid] = (F.tid < NEXP) ? (int)__hip_atomic_load(cnt + F.tid, __ATOMIC_RELAXED, __HIP_MEMORY_SCOPE_AGENT) : NTOK;
    __syncthreads();
    if (F.tid == 0) { int o = 0, u = 0; for (int e = 0; e < NE1; ++e) { eoff[e] = o; ustart[e] = u; o += ecnt[e]; u += (ecnt[e] + 255) >> 8; } ustart[NE1] = u; eoff[NE1] = o; }
    __syncthreads();
    if (F.tid < NE1) { LAS unsigned short* tmap = (LAS unsigned short*)(ecnt + 264); for (int t = ustart[F.tid]; t < ustart[F.tid + 1]; ++t) tmap[t] = (unsigned short)F.tid; }
    __syncthreads();
}
__device__ __forceinline__ void scatter_phase(const Frame& F, const int* EI, const float* TKW, int* INV, int* RTOK, float* RW) {
    const LAS int* eoff = (const LAS int*)(F.lds + LDS_TAB) + 264;
    for (int a = F.gw * 64 + F.lane; a < NASSIGN; a += F.NGW * 64) { const int ei = EI[a];
        const int pos = eoff[ei & 255] + (int)((unsigned)ei >> 8);
        INV[a] = pos; RTOK[pos] = a >> 3; RW[pos] = TKW[a]; }
    for (int t = F.gw * 64 + F.lane; t < NTOK; t += F.NGW * 64) { RTOK[NASSIGN + t] = t; RW[NASSIGN + t] = 1.0f; }
}

#ifndef MK_PER_PHASE
#define MK_PER_PHASE 0
#endif
constexpr int NPHASE = 1 + 12 * DEPTH;
struct Args { const float* in[24]; float* out; unsigned char* ws; int p_lo, p_hi; };
static_assert(sizeof(Args) == 216, "kernarg layout (karg_* offsets)");

__global__ void __launch_bounds__(NTHREADS, 2) fwd_kernel(Args args) {
    extern __shared__ __attribute__((aligned(16))) unsigned char lds_raw[];
    LAS unsigned char* const lds = (LAS unsigned char*)lds_raw;
#define MKFRAME() Frame F; { F.lds = lds; F.lane = lane_now(); F.wave = opaque_s(wv_); F.tid = F.wave * 64 + F.lane; \
        F.G = opaque_s((int)gridDim.x); const int bx = opaque_s((int)blockIdx.x); F.vcu = (F.G % 8 == 0) ? (bx % 8) * (F.G / 8) + bx / 8 : bx; F.gw = F.vcu * NWAVES + F.wave; F.NGW = F.G * NWAVES; } \
        const int cidx = opaque_s((int)blockIdx.x); (void)cidx;
    volatile LAS unsigned* MISC = (volatile LAS unsigned*)(lds + LDS_MISC);
    const int wv_ = opaque_s(__builtin_amdgcn_readfirstlane((int)threadIdx.x >> 6));
    if (threadIdx.x < 64) MISC[threadIdx.x] = 0u;
    __syncthreads();
    const int lo = args.p_lo, hi = args.p_hi;
    XcdBarrier bar; bar.bar = (unsigned*)(args.ws + WS_CTL) + CW_BAR; bar.x = 0; bar.st = nullptr; bar.wv = wv_;
    if (hi - lo > 1) bar = xcd_barrier_post((unsigned*)(args.ws + WS_CTL) + CW_BAR, MISC + 8, wv_);
#ifdef ONLY_PHASE
#define IN(k) ((((k) == 0) ? 0 : (((k) - 1) % 12) + 1) == ONLY_PHASE && lo <= (k) && (k) < hi)
#else
#define IN(k) (lo <= (k) && (k) < hi)
#endif
#define SEAM(k) do { if (IN(k) && IN((k) + 1)) xcd_barrier(bar); } while (0)
#ifndef PROBE_DUP
#define PROBE_DUP -1
#endif
#ifndef PROBE_REPSEL
#define PROBE_REPSEL -1
#endif
#define REPS(ptype) for (int rep_ = 0; rep_ < ((PROBE_DUP == (ptype)) ? 2 : 1); ++rep_)
#define WSP(T, off) ((T*)(ws + (off)))

    if (IN(0)) REPS(0) { MKFRAME(); const kargp_t kp = karg_base(); unsigned char* ws = karg_ws(kp);
        build_rope(F, ws); convert_x(F, karg_in(kp, 0), WSP(bf16_t, WS_XBF), WSP(unsigned char, WS_XB)); convert_small_weights(F, kp, ws, 0); convert_small_weights(F, kp, ws, 1); __syncthreads(); }
    SEAM(0);

    for (int l = 0; l < DEPTH; ++l) {
        const int pb = 1 + 12 * l;
        if (IN(pb + 0)) REPS(1) { MKFRAME(); const kargp_t kp = karg_base(); unsigned char* ws = karg_ws(kp); const unsigned char* wb = ws + WS_WSMALL + (size_t)l * WSMALL_LAYER;
            { typedef pg8::DenseOrderT<(PROBE_REPSEL == 1) ? 2 : 1> SchedT; SchedT S; S.init(NTOK, 2048, F.G, cidx, 512, (const bf16_t*)(wb + WOF_IN), 512);
              pg8::EpiP1 E{WSP(bf16_t, WS_QKV), WSP(bf16_t, WS_DQKV), WSP(bf16_t, WS_KR), WSP(bf16_t, WS_GATES), WSP(float, WS_SSQ), WSP(float, WS_LOGF), karg_in(kp, 6) + l * 3072, karg_in(kp, 7) + l * 4,
                           WSP(const float, WS_ROPE), WSP(const float, WS_ROPE) + SEQ * 16};
              pg8::gemm_phase<pg8::EpiP1, SchedT, true>(F.lds, F.tid, WSP(const bf16_t, WS_XB), 512, 512, S, E); }
            { typedef pg8::DenseOrderT<(PROBE_REPSEL == 1) ? 2 : 1> SchedT; SchedT S; S.init(NTOK, 3072, F.G, cidx, 512, (const bf16_t*)(wb + WOF_IN + 4 * MiB), 512);
              pg8::EpiGate E{WSP(bf16_t, WS_GATES), karg_in(kp, 6) + l * 3072};
              pg8::gemm_phase<pg8::EpiGate, SchedT, true>(F.lds, F.tid, WSP(const bf16_t, WS_XB), 512, 512, S, E); }
        }
        SEAM(pb + 0);
        if (IN(pb + 1)) REPS(2) { MKFRAME(); const kargp_t kp = karg_base(); unsigned char* ws = karg_ws(kp); const unsigned char* wb = ws + WS_WSMALL + (size_t)l * WSMALL_LAYER;
            cumf_phase(F, ws);
            for (int q = 0; q < 2; ++q) {
                pg8::DenseOrder S; S.init(NTOK, q ? 1024 : 768, F.G, cidx, 512, (const bf16_t*)(wb + (q ? WOF_UKV : WOF_UQ)), 256);
                pg8::EpiQK E{q ? WSP(bf16_t, WS_KVM) : WSP(bf16_t, WS_QM), q ? 1024 : 768, WSP(const float, WS_SSQ) + (q ? 4 : 0), q ? (1.0f / 128.0f) : (1.0f / 256.0f), q ? 1.0f : QS96, q ? -1 : 2,
                             WSP(const float, WS_ROPE), WSP(const float, WS_ROPE) + SEQ * 16};
                pg8::gemm_phase<pg8::EpiQK, pg8::DenseOrder, true>(F.lds, F.tid, WSP(const bf16_t, WS_DQKV) + (q ? 256 : 0), 256, 256, S, E);
            }
        }
        SEAM(pb + 1);
        if (IN(pb + 2)) REPS(3) { MKFRAME(); const kargp_t kp = karg_base(); unsigned char* ws = karg_ws(kp);
            const AttnPtrs AP{WSP(const bf16_t, WS_QKV), WSP(const bf16_t, WS_QM), WSP(const bf16_t, WS_KVM), WSP(const bf16_t, WS_KR), WSP(const float, WS_CUMF), WSP(unsigned char, WS_OCAT)};
            const int cslot = (F.vcu >> 2) % 9; int u = 0; bool conv = false;
            for (int item = F.vcu; item < 1024; item += F.G)
                for (int k = 0; k < 2; ++k, ++u) {
                    if (u == cslot) { __syncthreads(); convert_expert_weights(F, kp, ws, l); __syncthreads(); conv = true; }
                    attn_item(F.lds, F.wave, AP, item, k); }
            if (!conv) { __syncthreads(); convert_expert_weights(F, kp, ws, l); __syncthreads(); } }
        SEAM(pb + 2);
        if (IN(pb + 3)) REPS(4) { MKFRAME(); const kargp_t kp = karg_base(); unsigned char* ws = karg_ws(kp); const unsigned char* wb = ws + WS_WSMALL + (size_t)l * WSMALL_LAYER;
            typedef pg8::DenseOrderT<(PROBE_REPSEL == 4) ? 2 : 1> SchedT; SchedT S; S.init(NTOK, 1024, F.G, cidx, 512, (const bf16_t*)(wb + WOF_PSB), 512);
            pg8::EpiMix E{WSP(bf16_t, WS_MIXG), WSP(const bf16_t, WS_GATES)};
            pg8::gemm_phase<pg8::EpiMix, SchedT, true>(F.lds, F.tid, WSP(const bf16_t, WS_OCAT), 512, 512, S, E);
        }
        SEAM(pb + 3);
        if (IN(pb + 4)) REPS(5) { MKFRAME(); const kargp_t kp = karg_base(); unsigned char* ws = karg_ws(kp); const unsigned char* wb = ws + WS_WSMALL + (size_t)l * WSMALL_LAYER;
            typedef pg8::DenseOrderT<(PROBE_REPSEL == 5) ? 2 : 1> SchedT; SchedT S; S.init(NTOK, 1024, F.G, cidx, 512, (const bf16_t*)(wb + WOF_OUT3), 512);
            pg8::EpiY E{WSP(bf16_t, WS_Y), (l == 0) ? karg_in(kp, 0) : nullptr, WSP(const bf16_t, WS_XBF)};
            pg8::gemm_phase<pg8::EpiY, SchedT, true>(F.lds, F.tid, WSP(const bf16_t, WS_MIXG), 512, 512, S, E);
        }
        SEAM(pb + 4);
        if (IN(pb + 5)) REPS(6) { MKFRAME(); const kargp_t kp = karg_base(); unsigned char* ws = karg_ws(kp);
            ln1_phase(F, WSP(const bf16_t, WS_Y), karg_in(kp, 1) + l * DM, karg_in(kp, 2) + l * DM, WSP(float, WS_STATS), WSP(bf16_t, WS_XBF), WSP(unsigned char, WS_XA)); }
        SEAM(pb + 5);
        if (IN(pb + 6)) REPS(7) { MKFRAME(); const kargp_t kp = karg_base(); unsigned char* ws = karg_ws(kp); const unsigned char* wb = ws + WS_WSMALL + (size_t)l * WSMALL_LAYER;
            pg8::DenseOrder S; S.init(NTOK, 256, F.G, cidx, 1024, (const bf16_t*)(wb + WOF_R), 1024);
            pg8::EpiRouter E{WSP(float, WS_LOGITS)};
            pg8::gemm_phase<pg8::EpiRouter, pg8::DenseOrder, true>(F.lds, F.tid, WSP(const bf16_t, WS_XBF), 1024, 1024, S, E);
        }
        SEAM(pb + 6);
        if (IN(pb + 7)) { MKFRAME(); const kargp_t kp = karg_base(); unsigned char* ws = karg_ws(kp);
            route_phase(F, WSP(const float, WS_LOGITS), karg_in(kp, 17) + l * NEXP, WSP(int, WS_TKI), WSP(float, WS_TKW), WSP(unsigned, WS_CTL) + CW_CNT + l * 1024); __syncthreads(); }
        SEAM(pb + 7);
        if (IN(pb + 8)) { MKFRAME(); const kargp_t kp = karg_base(); unsigned char* ws = karg_ws(kp); unsigned* cnt = WSP(unsigned, WS_CTL) + CW_CNT + l * 1024;
            moe_tables(F, cnt); scatter_phase(F, WSP(const int, WS_TKI), WSP(const float, WS_TKW), WSP(int, WS_INV), WSP(int, WS_RTOK), WSP(float, WS_RW)); __syncthreads(); }
        SEAM(pb + 8);
        if (IN(pb + 9)) REPS(10) { MKFRAME(); const kargp_t kp = karg_base(); unsigned char* ws = karg_ws(kp);
            moe_tables(F, WSP(unsigned, WS_CTL) + CW_CNT + l * 1024);
            const LAS int* ustart = (const LAS int*)(F.lds + LDS_TAB);
            pg8::MoeOrder S{ustart, ustart + 264, ustart + 528, ustart[NE1], 2, F.G, F.vcu, WSP(const int, WS_RTOK), 512, WSP(const bf16_t, WS_WGU), 512, (size_t)512 * 1024};
            pg8::EpiGU E{WSP(bf16_t, WS_H), WSP(const float, WS_RW), WSP(unsigned char, WS_YS) + 401 * MiB};
            pg8::gemm_phase<pg8::EpiGU, pg8::MoeOrder, true>(F.lds, F.tid, WSP(const bf16_t, WS_XA), 512, 512, S, E);
            __syncthreads();
        }
        SEAM(pb + 9);
        if (IN(pb + 10)) REPS(11) { MKFRAME(); const kargp_t kp = karg_base(); unsigned char* ws = karg_ws(kp);
            moe_tables(F, WSP(unsigned, WS_CTL) + CW_CNT + l * 1024);
            const LAS int* ustart = (const LAS int*)(F.lds + LDS_TAB);
            pg8::MoeOrder S{ustart, ustart + 264, ustart + 528, ustart[NE1], 4, F.G, F.vcu, nullptr, 128, WSP(const bf16_t, WS_WD), 128, (size_t)1024 * 256};
            pg8::EpiDown E{WSP(unsigned char, WS_YS), F.lds + LDS_TAB + 7168, F.lds + LDS_MISC + 1024, WSP(unsigned char, WS_YS) + 400 * MiB};
            pg8::gemm_phase<pg8::EpiDown, pg8::MoeOrder, true>(F.lds, F.tid, WSP(const bf16_t, WS_H), 128, 128, S, E);
            __syncthreads();
        }
        SEAM(pb + 10);
        if (IN(pb + 11)) REPS(12) { MKFRAME(); const kargp_t kp = karg_base(); unsigned char* ws = karg_ws(kp);
            combine_phase(F, WSP(const bf16_t, WS_Y), WSP(const float, WS_STATS), karg_in(kp, 1) + l * DM, karg_in(kp, 2) + l * DM, WSP(const unsigned char, WS_YS), WSP(const int, WS_INV),
                          karg_in(kp, 3) + l * DM, karg_in(kp, 4) + l * DM, (l == DEPTH - 1) ? karg_out(kp) : nullptr, (l == DEPTH - 1) ? nullptr : WSP(bf16_t, WS_XBF), WSP(unsigned char, WS_XB));
        }
        SEAM(pb + 11);
    }
#undef IN
#undef SEAM
#undef WSP
}

extern "C" void kernel_launch(void* const* d_in, const int* in_sizes, int n_in, void* d_out, int out_size, void* d_ws, size_t ws_size, hipStream_t stream) {
    static int grid = 0;
    if (grid == 0) {
        if (n_in != 24 || in_sizes[0] != NTOK * DM || out_size != NTOK * DM || ws_size < WS_END) {
            fprintf(stderr, "kernel_launch: unexpected shapes (n_in %d, in0 %d, out %d, ws %zu, need %zu); nothing launched\n", n_in, n_in > 0 ? in_sizes[0] : -1, out_size, ws_size, (size_t)WS_END); grid = -1; return; }
        int dev = 0, cus = 0;
        if (hipGetDevice(&dev) != hipSuccess || hipDeviceGetAttribute(&cus, hipDeviceAttributeMultiprocessorCount, dev) != hipSuccess) { grid = -1; return; }
        if (hipFuncSetAttribute((const void*)fwd_kernel, hipFuncAttributeMaxDynamicSharedMemorySize, LDS_BYTES) != hipSuccess) { fprintf(stderr, "kernel_launch: hipFuncSetAttribute failed\n"); grid = -1; return; }
        (void)hipGetLastError();
        grid = cus;
    }
    if (grid < 0) return;
    (void)hipMemsetAsync((char*)d_ws + WS_CTL, 0, CTL_BYTES, stream);
    Args a{};
    for (int i = 0; i < 24; ++i) a.in[i] = (const float*)d_in[i];
    a.out = (float*)d_out; a.ws = (unsigned char*)d_ws;
#if MK_PER_PHASE
    for (int p = 0; p < NPHASE; ++p) { a.p_lo = p; a.p_hi = p + 1; hipLaunchKernelGGL(fwd_kernel, dim3(grid), dim3(NTHREADS), LDS_BYTES, stream, a); }
#else
    a.p_lo = 0; a.p_hi = NPHASE;
    hipLaunchKernelGGL(fwd_kernel, dim3(grid), dim3(NTHREADS), LDS_BYTES, stream, a);
#endif
}
```
